# Optimizing an MI355X kernel written in HIP

```python
import jax
import jax.numpy as jnp
from jax import lax
import numpy as np

D_MODEL = 2048
BATCH = 32
SEQ = 256
DEPTH = 4
DEC_BATCH = 8
DEC_SEQ = 2048
PAST_LEN = 256

GRID_W = 64
RMS_EPS = 1e-6
N_EVEN = (DEPTH + 1) // 2
N_ODD = DEPTH // 2
A_WIDTH = D_MODEL // 2
A_HEAD = 64
A_HEADS = A_WIDTH // A_HEAD
LORA = 64
GN_EPS = 64e-5
B_WIDTH = D_MODEL - A_WIDTH
B_GROUPS = 4
B_GROUP_CH = B_WIDTH // B_GROUPS
SHIFT_COLS = 3 * A_WIDTH + 4 * LORA
EVEN_IN = SHIFT_COLS + A_WIDTH + 2 * B_WIDTH
C_HEAD = 64
C_HEADS = D_MODEL // C_HEAD
C_KV_HEADS = C_HEADS // 4
C_GROUP = C_HEADS // C_KV_HEADS
WINDOW = 128
BLOCK = 128
ROPE_BASE = 10000.0
ODD_IN = (C_HEADS + 2 * C_KV_HEADS) * C_HEAD + D_MODEL
NEG_INF = -1e30

kernel_name = 'hybrid_rwkv7_fnet_swa_dit_step'


def _rmsnorm(x, g):
    x32 = x.astype(jnp.float32)
    y = x32 * lax.rsqrt(jnp.mean(x32 * x32, axis=-1, keepdims=True) + RMS_EPS)
    return (y * g.astype(jnp.float32)).astype(x.dtype)


def _modulation(cond, w, b):
    m = (jax.nn.silu(cond) @ w + b)[..., None, :]
    return jnp.split(m, 3, axis=-1)


def _centred_shift(p):
    zero = jnp.zeros_like(p[:, :1])
    prev = jnp.concatenate([zero, p[:, :-1]], axis=1)
    nxt = jnp.concatenate([p[:, 1:], zero], axis=1)
    return 0.5 * (prev + nxt)


def _heads(t):
    return t.reshape(t.shape[:-1] + (A_HEADS, A_HEAD))


def _rev(t):
    return t[:, ::-1]


def _dirs(t):
    return jnp.stack([t[0], _rev(t[1])])


def _both(t):
    return jnp.stack([t, _rev(t)])


def _wkv_scan(w, kk, kka, k, v, r, s0):
    def step(s, inp):
        w_t, kk_t, kka_t, k_t, v_t, r_t = inp
        s = (s * w_t[..., None, :]
             - jnp.einsum('dbhij,dbhj->dbhi', s, kk_t)[..., None] * kka_t[..., None, :]
             + v_t[..., :, None] * k_t[..., None, :])
        return s, jnp.einsum('dbhij,dbhj->dbhi', s, r_t)
    xs = tuple(jnp.moveaxis(a, 2, 0) for a in (w, kk, kka, k, v, r))
    s_fin, o = lax.scan(step, s0, xs)
    return jnp.moveaxis(o, 0, 2), s_fin


def _rwkv_fourier_mixer(h, s0, w_in, mu, w0, w_up, a0, a_up, k_k, k_a, r_k, gn_w, gn_b, w_out):
    bsz, t_len, _ = h.shape
    f32 = jnp.float32
    proj = h @ w_in
    sh = proj[..., :SHIFT_COLS]
    sh = sh + mu * (_centred_shift(sh) - sh)
    r = sh[..., :A_WIDTH].astype(f32)
    k = sh[..., A_WIDTH:2 * A_WIDTH].astype(f32)
    v = sh[..., 2 * A_WIDTH:3 * A_WIDTH].astype(f32)
    low = sh[..., 3 * A_WIDTH:].reshape(bsz, t_len, 2, 2, LORA)
    w_low, a_low = low[:, :, 0], low[:, :, 1]
    o0 = SHIFT_COLS
    gate_a = proj[..., o0:o0 + A_WIDTH].astype(f32)
    u = proj[..., o0 + A_WIDTH:o0 + A_WIDTH + B_WIDTH].astype(f32)
    gate_b = proj[..., o0 + A_WIDTH + B_WIDTH:].astype(f32)

    w_raw = (w0[:, None, None] + jnp.einsum('btdl,dla->dbta', jnp.tanh(w_low), w_up)).astype(f32)
    decay = jnp.exp(-jnp.exp(-jax.nn.softplus(-w_raw) - 0.5))
    a = jax.nn.sigmoid((a0[:, None, None] + jnp.einsum('btdl,dla->dbta', a_low, a_up)).astype(f32))
    k_dir = k[None] * (1.0 + (a - 1.0) * k_a.astype(f32))
    kk = _heads(k * k_k.astype(f32))
    kk = kk / jnp.maximum(jnp.linalg.norm(kk, axis=-1, keepdims=True), 1e-12)
    rh, vh = _heads(r), _heads(v)
    o, s_fin = _wkv_scan(_dirs(_heads(decay)), _both(kk), _dirs(kk[None] * _heads(a)),
                         _dirs(_heads(k_dir)), _both(vh), _both(rh), s0.astype(f32))
    o = o[0] + _rev(o[1])
    mean = jnp.mean(o, axis=-1, keepdims=True)
    var = jnp.mean(jnp.square(o - mean), axis=-1, keepdims=True)
    o = ((o - mean) * lax.rsqrt(var + GN_EPS)).reshape(bsz, t_len, A_WIDTH)
    o = o * gn_w.astype(f32) + gn_b.astype(f32)
    bonus = jnp.sum(rh * _heads(jnp.mean(k_dir, axis=0)) * r_k.astype(f32), axis=-1, keepdims=True) * vh
    y_a = (o + bonus.reshape(bsz, t_len, A_WIDTH)) * jax.nn.silu(gate_a)

    ug = u.reshape(bsz, t_len, B_GROUPS, B_GROUP_CH)
    y_b = jnp.fft.fft2(ug, axes=(1, 3), norm='ortho').real.reshape(bsz, t_len, B_WIDTH)
    y_b = y_b * jax.nn.silu(gate_b)
    y = jnp.concatenate([y_a, y_b], axis=-1).astype(h.dtype) @ w_out
    return y, s_fin


def _axial_rope(x):
    t_len = x.shape[1]
    rows = t_len // GRID_W
    row = jnp.repeat(jnp.arange(rows), GRID_W)
    col = jnp.tile(jnp.arange(GRID_W), rows)
    half = C_HEAD // 2
    nf = half // 2
    inv = 1.0 / (ROPE_BASE ** (jnp.arange(nf, dtype=jnp.float32) / nf))
    shape = (1, t_len) + (1,) * (x.ndim - 3) + (nf,)

    def rot(seg, pos):
        ang = pos.astype(jnp.float32)[:, None] * inv
        cos, sin = jnp.cos(ang).reshape(shape), jnp.sin(ang).reshape(shape)
        s1, s2 = seg[..., :nf], seg[..., nf:]
        return jnp.concatenate([s1 * cos - s2 * sin, s2 * cos + s1 * sin], axis=-1)

    x32 = x.astype(jnp.float32)
    return jnp.concatenate([rot(x32[..., :half], row), rot(x32[..., half:], col)], axis=-1).astype(x.dtype)


def _attend(q, k, v, valid, sink):
    s = jnp.einsum('bqhgd,bkhd->bhgqk', q, k).astype(jnp.float32) * (C_HEAD ** -0.5)
    if valid is not None:
        s = jnp.where(valid, s, NEG_INF)
    sink_col = jnp.broadcast_to(sink.astype(jnp.float32)[None, :, :, None, None], s.shape[:-1] + (1,))
    p = jax.nn.softmax(jnp.concatenate([s, sink_col], axis=-1), axis=-1)[..., :-1]
    return jnp.einsum('bhgqk,bkhd->bqhgd', p.astype(v.dtype), v)


def _attn_split(h, w_in):
    bsz, t_len, _ = h.shape
    proj = h @ w_in
    nq, nkv = C_HEADS * C_HEAD, C_KV_HEADS * C_HEAD
    q = proj[..., :nq].reshape(bsz, t_len, C_KV_HEADS, C_GROUP, C_HEAD)
    k = proj[..., nq:nq + nkv].reshape(bsz, t_len, C_KV_HEADS, C_HEAD)
    v = proj[..., nq + nkv:nq + 2 * nkv].reshape(bsz, t_len, C_KV_HEADS, C_HEAD)
    gate = proj[..., nq + 2 * nkv:]
    return q, k, v, gate


def _gated_out(o, gate, w_out):
    bsz, t_len = o.shape[:2]
    y = o.reshape(bsz, t_len, C_HEADS * C_HEAD).astype(jnp.float32) * jax.nn.silu(gate.astype(jnp.float32))
    return y.astype(gate.dtype) @ w_out


def _query_blocks(t):
    bsz, t_len = t.shape[:2]
    return jnp.moveaxis(t.reshape((bsz, t_len // BLOCK, BLOCK) + t.shape[2:]), 1, 0)


def _merge_blocks(o):
    nb, bsz = o.shape[:2]
    return jnp.moveaxis(o, 0, 1).reshape((bsz, nb * BLOCK) + o.shape[3:])


def _attention_context(h, w_in, sink, w_out):
    q, k, v, gate = _attn_split(h, w_in)
    sink = sink.reshape(C_KV_HEADS, C_GROUP)
    o = lax.map(lambda qb: _attend(qb, k, v, None, sink), _query_blocks(q))
    return _gated_out(_merge_blocks(o), gate, w_out), k, v


def _attention_latent(h, ctx_k, ctx_v, w_in, sink, w_out):
    q, k, v, gate = _attn_split(h, w_in)
    q, k = _axial_rope(q), _axial_rope(k)
    bsz, t_len = h.shape[:2]
    nb = t_len // BLOCK
    pad = ((0, 0), (BLOCK, BLOCK), (0, 0), (0, 0))
    kp = jnp.pad(k, pad).reshape(bsz, nb + 2, BLOCK, C_KV_HEADS, C_HEAD)
    vp = jnp.pad(v, pad).reshape(bsz, nb + 2, BLOCK, C_KV_HEADS, C_HEAD)

    def band(t):
        return jnp.moveaxis(jnp.concatenate([t[:, :-2], t[:, 1:-1], t[:, 2:]], axis=2), 1, 0)

    qpos = jnp.arange(nb)[:, None, None] * BLOCK + jnp.arange(BLOCK)[None, :, None]
    kpos = jnp.arange(nb)[:, None, None] * BLOCK - BLOCK + jnp.arange(3 * BLOCK)[None, None, :]
    valid = (jnp.abs(qpos - kpos) <= WINDOW) & (kpos >= 0) & (kpos < t_len)
    valid = jnp.concatenate([valid, jnp.ones((nb, BLOCK, ctx_k.shape[1]), dtype=bool)], axis=-1)
    sink = sink.reshape(C_KV_HEADS, C_GROUP)

    def blk(args):
        qi, ki, vi, mi = args
        return _attend(qi, jnp.concatenate([ki, ctx_k], axis=1), jnp.concatenate([vi, ctx_v], axis=1), mi, sink)

    o = lax.map(blk, (_query_blocks(q), band(kp), band(vp), valid))
    return _gated_out(_merge_blocks(o), gate, w_out)


def setup_inputs(seed: int = 0) -> dict:
    key = jax.random.key(seed)
    ks = iter(jax.random.split(key, 32))
    f32 = jnp.float32

    def nrm(shape, scale):
        return jax.random.normal(next(ks), shape, f32) * scale

    def unif(shape, lo, hi):
        return jax.random.uniform(next(ks), shape, f32, lo, hi)

    d = D_MODEL
    return {
        'x_prompt': nrm((BATCH, SEQ, d), 1.0),
        'x_sample': nrm((DEC_BATCH, DEC_SEQ, d), 1.0),
        'c': nrm((DEC_BATCH, d), 1.0),
        'state_wkv': nrm((DEC_BATCH, N_EVEN, 2, A_HEADS, A_HEAD, A_HEAD), 0.5),
        'cache_k': nrm((DEC_BATCH, N_ODD, PAST_LEN, C_KV_HEADS, C_HEAD), 1.0),
        'cache_v': nrm((DEC_BATCH, N_ODD, PAST_LEN, C_KV_HEADS, C_HEAD), 1.0),
        'c_ctx': nrm((d,), 1.0),
        'mod_w': nrm((DEPTH, d, 3 * d), 0.5 * d ** -0.5),
        'mod_b': nrm((DEPTH, 3 * d), 0.01),
        'norm_pre': 1.0 + nrm((DEPTH, d), 0.05),
        'norm_post': 1.0 + nrm((DEPTH, d), 0.05),
        'even_w_in': nrm((N_EVEN, d, EVEN_IN), d ** -0.5),
        'even_mu': unif((N_EVEN, SHIFT_COLS), 0.0, 1.0),
        'even_w0': unif((N_EVEN, 2, A_WIDTH), -4.0, 1.0),
        'even_w_up': nrm((N_EVEN, 2, LORA, A_WIDTH), 0.5 * LORA ** -0.5),
        'even_a0': nrm((N_EVEN, 2, A_WIDTH), 0.5),
        'even_a_up': nrm((N_EVEN, 2, LORA, A_WIDTH), 0.5 * LORA ** -0.5),
        'even_k_k': 0.85 + nrm((N_EVEN, A_WIDTH), 0.05),
        'even_k_a': 1.0 + nrm((N_EVEN, A_WIDTH), 0.05),
        'even_r_k': nrm((N_EVEN, A_HEADS, A_HEAD), 0.1),
        'even_gn_w': 1.0 + nrm((N_EVEN, A_WIDTH), 0.05),
        'even_gn_b': nrm((N_EVEN, A_WIDTH), 0.01),
        'even_w_out': nrm((N_EVEN, d, d), d ** -0.5),
        'odd_w_in': nrm((N_ODD, d, ODD_IN), d ** -0.5),
        'odd_sink': nrm((N_ODD, C_HEADS), 1.0),
        'odd_w_out': nrm((N_ODD, d, d), d ** -0.5),
    }


def reference(x_prompt, x_sample, c, state_wkv, cache_k, cache_v, c_ctx, mod_w, mod_b, norm_pre, norm_post,
              even_w_in, even_mu, even_w0, even_w_up, even_a0, even_a_up, even_k_k, even_k_a, even_r_k,
              even_gn_w, even_gn_b, even_w_out, odd_w_in, odd_sink, odd_w_out):
    xp, xs = x_prompt, x_sample
    new_wkv, new_k, new_v = [], [], []
    for layer in range(DEPTH):
        i = layer // 2
        sh_p, sc_p, g_p = _modulation(c_ctx, mod_w[layer], mod_b[layer])
        sh_s, sc_s, g_s = _modulation(c, mod_w[layer], mod_b[layer])
        hp = _rmsnorm(xp, norm_pre[layer]) * (1.0 + sc_p) + sh_p
        hs = _rmsnorm(xs, norm_pre[layer]) * (1.0 + sc_s) + sh_s
        if layer % 2 == 0:
            p = (even_w_in[i], even_mu[i], even_w0[i], even_w_up[i], even_a0[i], even_a_up[i],
                 even_k_k[i], even_k_a[i], even_r_k[i], even_gn_w[i], even_gn_b[i], even_w_out[i])
            s0 = jnp.zeros((2, xp.shape[0], A_HEADS, A_HEAD, A_HEAD), jnp.float32)
            yp, s_ctx = _rwkv_fourier_mixer(hp, s0, *p)
            ys, _ = _rwkv_fourier_mixer(hs, jnp.moveaxis(state_wkv[:, i], 1, 0), *p)
            new_wkv.append(jnp.moveaxis(s_ctx, 0, 1))
        else:
            yp, kc, vc = _attention_context(hp, odd_w_in[i], odd_sink[i], odd_w_out[i])
            ys = _attention_latent(hs, cache_k[:, i], cache_v[:, i], odd_w_in[i], odd_sink[i], odd_w_out[i])
            new_k.append(kc)
            new_v.append(vc)
        xp = xp + g_p * _rmsnorm(yp, norm_post[layer])
        xs = xs + g_s * _rmsnorm(ys, norm_post[layer])
    new_state_wkv = jnp.stack(new_wkv, axis=1)
    new_cache_k = jnp.stack(new_k, axis=1)
    new_cache_v = jnp.stack(new_v, axis=1)
    return (xp, xs, new_state_wkv, new_cache_k, new_cache_v)
```

```cpp
#include <hip/hip_runtime.h>
#include <hip/hip_fp16.h>
#include <hip/hip_cooperative_groups.h>
#include <cstdio>
namespace cg = cooperative_groups;

typedef _Float16 h16;
typedef __attribute__((ext_vector_type(8))) _Float16 h16x8;
typedef __attribute__((ext_vector_type(4))) _Float16 h16x4;
typedef __attribute__((ext_vector_type(4))) float f32x4;
typedef __attribute__((ext_vector_type(2))) float f32x2;

#ifndef COOP
#define COOP 1
#endif

constexpr int NT = 24576;
constexpr int NPR = 8192;
constexpr int DM = 2048;
constexpr int NTHR = 512;
constexpr size_t SMEM_BYTES = 140288 + 16;
constexpr size_t XCD_BAR_WORDS_C = 3456;

constexpr size_t SZ_WT = (size_t)7424 * 2048 * 2;
constexpr size_t OFF_WT = 0;
constexpr size_t OFF_WO = OFF_WT + SZ_WT;
constexpr size_t OFF_WU = OFF_WO + (size_t)2048 * 2048 * 2;
constexpr size_t OFF_TWC = OFF_WU + (size_t)2 * 2048 * 1024 * 2;
constexpr size_t OFF_TW2048 = OFF_TWC + (size_t)2 * 256 * 256 * 2;
constexpr size_t OFF_TW256 = OFF_TW2048 + (size_t)2048 * 4096 * 2;
constexpr size_t OFF_MOD = OFF_TW256 + (size_t)256 * 512 * 2;
constexpr size_t OFF_ROPE = OFF_MOD + (size_t)4 * 9 * 6144 * 4;
constexpr size_t OFF_LW = OFF_ROPE + (size_t)64 * 16 * 2 * 4;
constexpr size_t OFF_RN = OFF_LW + (size_t)8 * 1024 * 64 * 2;
constexpr size_t OFF_H = OFF_RN + (size_t)NT * 16 * 4;
constexpr size_t OFF_PA = OFF_H + (size_t)NT * 2048 * 2;
constexpr size_t OFF_PB = OFF_PA + (size_t)NT * 3328 * 2;
constexpr size_t OFF_C = OFF_PB + (size_t)NT * 4096 * 2;
constexpr size_t WS_NEED = OFF_C + (size_t)NT * 1024 * 2 * 5;
constexpr size_t OFF_BAR = WS_NEED;
constexpr size_t OFF_CK = OFF_BAR + 16384;
constexpr size_t CACHE_ELEMS = (size_t)8 * 2 * 256 * 512;
constexpr size_t OFF_CV = OFF_CK + CACHE_ELEMS * 2;
constexpr size_t OFF_PART = OFF_CV + CACHE_ELEMS * 2;
constexpr size_t WS_TOTAL = OFF_PART + (size_t)4 * 8 * 9 * 6144 * 4;
constexpr size_t NT1K = (size_t)NT * 1024;

constexpr size_t OUT_STATE = (size_t)NT * 2048;
constexpr size_t OUT_K = OUT_STATE + (size_t)32 * 2 * 2 * 16 * 64 * 64;
constexpr size_t OUT_V = OUT_K + (size_t)32 * 2 * 256 * 512;

struct Params {
  const float *x_prompt, *x_sample, *c, *state_wkv, *cache_k, *cache_v, *c_ctx, *mod_w, *mod_b, *norm_pre, *norm_post;
  const float *even_w_in, *even_mu, *even_w0, *even_w_up, *even_a0, *even_a_up, *even_k_k, *even_k_a, *even_r_k, *even_gn_w,
      *even_gn_b, *even_w_out;
  const float *odd_w_in, *odd_sink, *odd_w_out;
  float* out;
  char* ws;
};

extern __shared__ __attribute__((aligned(16))) char smem[];
__device__ __forceinline__ int lane_id_() {
  int l;
  asm volatile("v_mbcnt_lo_u32_b32 %0, -1, 0\n\tv_mbcnt_hi_u32_b32 %0, -1, %0" : "=v"(l));
  return l;
}
#define TIDX (swid * 64 + lane_id_())


__device__ __forceinline__ float wave_sum(float v) {
#pragma unroll
  for (int o = 32; o >= 1; o >>= 1) v += __shfl_xor(v, o);
  return v;
}
__device__ __forceinline__ float sigmoidf_(float x) { return __builtin_amdgcn_rcpf(1.f + __expf(-x)); }
__device__ __forceinline__ float siluf_(float x) { return x * __builtin_amdgcn_rcpf(1.f + __expf(-x)); }


#define XB_TMO      128
#define XB_XCNT(j)  (256  + 64 * (j))
#define XB_XSUB(j)  (1280 + 64 * (j))
#define XB_XGEN(j)  (2304 + 64 * (j))
#define XB_TOP      3328
#define XB_TOPGEN   3392
#define XCD_BAR_WORDS 3456
#define XB_SPIN_CAP (1u << 18)
#define LAS __attribute__((address_space(3)))
__device__ __forceinline__ unsigned xb_ld(unsigned* p) { return __hip_atomic_load(p, __ATOMIC_RELAXED, __HIP_MEMORY_SCOPE_AGENT); }
__device__ __forceinline__ unsigned xb_add(unsigned* p, unsigned v) { return __hip_atomic_fetch_add(p, v, __ATOMIC_RELAXED, __HIP_MEMORY_SCOPE_AGENT); }
__device__ __forceinline__ unsigned xb_xcc_id() { return (unsigned)__builtin_amdgcn_s_getreg((3 << 11) | 20) & 0xFu; }
#define XB_SPIN(cond, bar) do { unsigned _sp = 0; while (cond) { __builtin_amdgcn_s_sleep(1); \
    if ((++_sp & 255u) == 0u) { if (xb_ld(&(bar)[XB_TMO])) break; if (_sp > XB_SPIN_CAP) { atomicAdd(&(bar)[XB_TMO], 1u); break; } } } } while (0)
struct XcdBarrier { unsigned* bar; unsigned x; volatile LAS unsigned* st; };
__device__ __forceinline__ void xcd_barrier_complete(unsigned* bar, unsigned x, unsigned& nloc, unsigned& nx) {
  const unsigned G = gridDim.x;
  unsigned sum, cnt, mine, sp = 0u;
  for (;;) {
    sum = 0u; cnt = 0u; mine = 0u;
#pragma unroll
    for (unsigned j = 0; j < 16; ++j) { const unsigned c = xb_ld(&bar[XB_XCNT(j)]); sum += c; cnt += (c > 0u) ? 1u : 0u; mine = (j == x) ? c : mine; }
    if (sum == G) break;
    __builtin_amdgcn_s_sleep(1);
    if ((++sp & 255u) == 0u) { if (xb_ld(&bar[XB_TMO])) break; if (sp > XB_SPIN_CAP) { atomicAdd(&bar[XB_TMO], 1u); break; } }
  }
  nloc = mine > 0u ? mine : 1u; nx = cnt > 0u ? cnt : 1u;
}
__device__ __forceinline__ void xcd_barrier(const XcdBarrier& b, const bool leader_thread) {
  asm volatile("s_waitcnt vmcnt(0)" ::: "memory");
  __syncthreads();
  if (leader_thread) {
    unsigned* bar = b.bar;
    __builtin_amdgcn_s_waitcnt(0);
    unsigned nloc = b.st[0], nx = b.st[1];
    if (nloc == 0u) { xcd_barrier_complete(bar, b.x, nloc, nx); b.st[0] = nloc; b.st[1] = nx; }
    const unsigned old = xb_add(&bar[XB_XSUB(b.x)], 1u);
    const unsigned gen = old / nloc;
    if (old + 1u == (gen + 1u) * nloc) {
      __builtin_amdgcn_fence(__ATOMIC_RELEASE, "agent");
      asm volatile("s_waitcnt vmcnt(0)" ::: "memory");
      const unsigned og = xb_add(&bar[XB_TOP], 1u);
      const unsigned tg = og / nx;
      if (og + 1u == (tg + 1u) * nx) xb_add(&bar[XB_TOPGEN], 1u);
      else XB_SPIN(xb_ld(&bar[XB_TOPGEN]) == tg, bar);
      __builtin_amdgcn_fence(__ATOMIC_ACQUIRE, "agent");
      xb_add(&bar[XB_XGEN(b.x)], 1u);
      asm volatile("s_waitcnt vmcnt(0)" ::: "memory");
    } else {
      XB_SPIN(xb_ld(&bar[XB_XGEN(b.x)]) == gen, bar);
      __builtin_amdgcn_fence(__ATOMIC_ACQUIRE, "agent");
      asm volatile("s_waitcnt vmcnt(0)" ::: "memory");
    }
  }
  __syncthreads();
}

constexpr int BK = 64, HALF = 128, HT = HALF * BK;

__device__ __forceinline__ int lds_byte(int r, int c) {
  int st = (r >> 4) * 2 + (c >> 5), rr = r & 15, cc = c & 31, ob = rr * 64 + cc * 2;
  return st * 1024 + (ob ^ (((ob >> 9) & 1) << 5));
}
__device__ __forceinline__ void stage_rc(int b, int& R, int& C) {
  int st = b / 1024, sb = b % 1024, swz = sb ^ (((sb >> 9) & 1) << 5);
  R = (st >> 1) * 16 + swz / 64;
  C = (st & 1) * 32 + (swz % 64) / 2;
}

constexpr float QSC = 0.18033688011112042f;
enum { M_EVEN_IN = 0, M_OUT_F32 = 1, M_ODD_IN = 2, M_FOLD = 3, M_DFT2 = 4 };

struct Epi {
  h16* o0;
  h16* o1;
  h16* o2;
  h16* o3;
  float* f0;
  float* f1;
  const float* rope;
  int il;
  int aux;
  float scale;
};

__device__ __forceinline__ float4 cs_ld4(const float* cs, int r, int c) {
  return *reinterpret_cast<const float4*>(cs + r * 256 + (c ^ (((r >> 2) & 3) << 4)));
}
__device__ __forceinline__ float cs_ld1(const float* cs, int r, int c) { return cs[r * 256 + (c ^ (((r >> 2) & 3) << 4))]; }
__device__ __forceinline__ h16x4 cvt4(float4 v) {
  h16x4 o;
  o[0] = (h16)v.x; o[1] = (h16)v.y; o[2] = (h16)v.z; o[3] = (h16)v.w;
  return o;
}

template <int MODE>
__device__ __forceinline__ void epi_store(const int swid, const float* cs, int grow0, int bcol, const Epi& e) {
  const int tid = TIDX, wid = tid >> 6, lane = tid & 63;
  if (MODE == M_EVEN_IN && bcol >= 4352 && bcol < 6400) {
    size_t sbase;
    int T, t0;
    if (grow0 < NPR) { sbase = (size_t)(grow0 >> 8) * 524288; T = 256; t0 = grow0 & 255; }
    else { int r2 = grow0 - NPR; sbase = (size_t)16777216 + (size_t)(r2 >> 11) * 4194304; T = 2048; t0 = r2 & 2047; }
#pragma unroll 1
    for (int it = 0; it < 2; ++it) {
      const int idx = it * 512 + tid;
      const int col = idx & 255, rg = idx >> 8;
      const int np = bcol + col - 4352;
      const int csn = np >> 10, gf = np & 1023;
      h16* dst = e.o2 + sbase + ((size_t)gf * 2 + csn) * T + t0 + rg * 32;
#pragma unroll
      for (int part = 0; part < 4; ++part) {
        h16x8 o;
#pragma unroll
        for (int q = 0; q < 8; ++q) o[q] = (h16)cs_ld1(cs, rg * 32 + part * 8 + q, col);
        *reinterpret_cast<h16x8*>(dst + part * 8) = o;
      }
    }
    return;
  }
  if (MODE == M_ODD_IN && bcol < 2560) {
    const bool sample = grow0 >= NPR;
    const bool isq = bcol < 2048;
#pragma unroll 1
    for (int it = 0; it < 8; ++it) {
      const int r = it * 16 + wid * 2 + (lane >> 5);
      const int l5 = lane & 31, grp = l5 >> 2, sub = l5 & 3;
      const int c = grp * 32 + sub * 4;
      const int row = grow0 + r;
      float4 v1 = cs_ld4(cs, r, c), v2 = cs_ld4(cs, r, c + 16);
      float4 r1 = v1, r2 = v2;
      if (sample) {
        const int t = (row - NPR) & 2047;
        const int pos = (grp & 1) ? (t & 63) : (t >> 6);
        const float4 ra = *reinterpret_cast<const float4*>(e.rope + (pos * 16 + sub * 4) * 2);
        const float4 rb = *reinterpret_cast<const float4*>(e.rope + (pos * 16 + sub * 4) * 2 + 4);
        r1.x = v1.x * ra.x - v2.x * ra.y; r2.x = v2.x * ra.x + v1.x * ra.y;
        r1.y = v1.y * ra.z - v2.y * ra.w; r2.y = v2.y * ra.z + v1.y * ra.w;
        r1.z = v1.z * rb.x - v2.z * rb.y; r2.z = v2.z * rb.x + v1.z * rb.y;
        r1.w = v1.w * rb.z - v2.w * rb.w; r2.w = v2.w * rb.z + v1.w * rb.w;
      }
      if (isq) {
        r1.x *= QSC; r1.y *= QSC; r1.z *= QSC; r1.w *= QSC;
        r2.x *= QSC; r2.y *= QSC; r2.z *= QSC; r2.w *= QSC;
        h16* dst = e.o0 + (size_t)row * 2048 + bcol + c;
        *reinterpret_cast<h16x4*>(dst) = cvt4(r1);
        *reinterpret_cast<h16x4*>(dst + 16) = cvt4(r2);
      } else {
        const int cp = bcol - 2048 + c;
        h16* dst = e.o1 + (size_t)row * 512 + cp;
        *reinterpret_cast<h16x4*>(dst) = cvt4(r1);
        *reinterpret_cast<h16x4*>(dst + 16) = cvt4(r2);
        if (!sample) {
          float* fo = e.f0 + ((size_t)((row >> 8) * 2 + e.il) * 256 + (row & 255)) * 512 + cp;
          *reinterpret_cast<float4*>(fo) = v1;
          *reinterpret_cast<float4*>(fo + 16) = v2;
        }
      }
    }
    return;
  }
#pragma unroll 1
  for (int it = 0; it < 8; ++it) {
    const int r = it * 16 + wid * 2 + (lane >> 5);
    const int c = (lane & 31) * 8;
    const int row = grow0 + r, col = bcol + c;
    const float4 va = cs_ld4(cs, r, c), vb = cs_ld4(cs, r, c + 4);
    h16x8 hv;
    hv[0] = (h16)va.x; hv[1] = (h16)va.y; hv[2] = (h16)va.z; hv[3] = (h16)va.w;
    hv[4] = (h16)vb.x; hv[5] = (h16)vb.y; hv[6] = (h16)vb.z; hv[7] = (h16)vb.w;
    if (MODE == M_OUT_F32 || MODE == M_FOLD) {
      *reinterpret_cast<h16x8*>(e.o0 + (size_t)row * 2048 + col) = hv;
    } else if (MODE == M_DFT2) {
      h16* ptr = e.o0 + (size_t)row * 1024 + e.aux + col;
      const h16x8 g = *reinterpret_cast<const h16x8*>(ptr);
      const float vv[8] = {va.x, va.y, va.z, va.w, vb.x, vb.y, vb.z, vb.w};
      h16x8 o;
#pragma unroll
      for (int q = 0; q < 8; ++q) o[q] = (h16)(vv[q] * e.scale * siluf_((float)g[q]));
      *reinterpret_cast<h16x8*>(ptr) = o;
    } else if (MODE == M_EVEN_IN) {
      if (bcol < 3328) *reinterpret_cast<h16x8*>(e.o0 + (size_t)row * 3328 + col) = hv;
      else if (bcol < 4352) *reinterpret_cast<h16x8*>(e.o1 + (size_t)row * 1024 + (col - 3328)) = hv;
      else *reinterpret_cast<h16x8*>(e.o3 + (size_t)row * 1024 + (col - 6400)) = hv;
    } else if (MODE == M_ODD_IN) {
      const bool sample = grow0 >= NPR;
      if (bcol < 3072) {
        const int cp = col - 2560;
        *reinterpret_cast<h16x8*>(e.o2 + (size_t)row * 512 + cp) = hv;
        if (!sample) {
          float* fo = e.f1 + ((size_t)((row >> 8) * 2 + e.il) * 256 + (row & 255)) * 512 + cp;
          *reinterpret_cast<float4*>(fo) = va;
          *reinterpret_cast<float4*>(fo + 4) = vb;
        }
      } else {
        *reinterpret_cast<h16x8*>(e.o3 + (size_t)row * 2048 + (col - 3072)) = hv;
      }
    }
  }
}

template <int MODE>
__device__ __forceinline__ void gemm_tile(const int swid, const h16* __restrict__ A0, const h16* __restrict__ A1, int ksplit, int lda,
                                          const h16* __restrict__ Bt, int ldb, int K, int brow, int bcol, const Epi& e) {
  h16* shm = (h16*)smem;
  asm volatile("" : "+s"(K), "+s"(lda), "+s"(ldb));
#define SA(b, h) (shm + ((b) * 2 + (h)) * HT)
#define SB(b, h) (shm + (4 + (b) * 2 + (h)) * HT)
#define STAGE_A(P, br, kt)                                                                                      \
  do {                                                                                                          \
    unsigned long long _ub = (unsigned long long)((((kt) < ksplit) ? (A0 + (long)(kt) * BK) : (A1 + (long)((kt) - ksplit) * BK)) + (long)(br) * lda); \
    asm volatile("" : "+s"(_ub)); \
    __builtin_amdgcn_global_load_lds((const unsigned*)((const char*)_ub + offA0), (unsigned*)((char*)(P) + swid * 1024), 16, 0, 0); \
    __builtin_amdgcn_global_load_lds((const unsigned*)((const char*)_ub + offA1), (unsigned*)((char*)(P) + swid * 1024 + 8192), 16, 0, 0); \
  } while (0)
#define STAGE_B(P, bc, kt)                                                                                      \
  do {                                                                                                          \
    unsigned long long _ub = (unsigned long long)(Bt + (long)(kt) * BK + (long)(bc) * ldb); \
    asm volatile("" : "+s"(_ub)); \
    __builtin_amdgcn_global_load_lds((const unsigned*)((const char*)_ub + offB0), (unsigned*)((char*)(P) + swid * 1024), 16, 0, 0); \
    __builtin_amdgcn_global_load_lds((const unsigned*)((const char*)_ub + offB1), (unsigned*)((char*)(P) + swid * 1024 + 8192), 16, 0, 0); \
  } while (0)
#define LDA(dst, b, h)                                                                                          \
  for (int m = 0; m < 4; ++m)                                                                                   \
    for (int k = 0; k < 2; ++k)                                                                                 \
  dst[m][k] = *reinterpret_cast<const h16x8*>(pa_lds + (((b) * 2 + (h)) * HT * 2 + m * 2048 + k * 1024))
#define LDB(dst, b, h)                                                                                          \
  for (int n = 0; n < 2; ++n)                                                                                   \
    for (int k = 0; k < 2; ++k)                                                                                 \
  dst[n][k] = *reinterpret_cast<const h16x8*>(pb_lds + (((4 + (b) * 2 + (h)) * HT * 2) + n * 2048 + k * 1024))
#define MMA(ai, bj, At, Bq)                                                                                     \
  do {                                                                                                          \
    __builtin_amdgcn_s_setprio(1);                                                                              \
    for (int m = 0; m < 4; ++m)                                                                                 \
      for (int n = 0; n < 2; ++n)                                                                               \
        for (int k = 0; k < 2; ++k)                                                                             \
          acc[ai][bj][m][n] = __builtin_amdgcn_mfma_f32_16x16x32_f16(At[m][k], Bq[n][k], acc[ai][bj][m][n], 0, 0, 0); \
    __builtin_amdgcn_s_setprio(0);                                                                              \
  } while (0)
#define WAIT_V(n) asm volatile("s_waitcnt vmcnt(" #n ")" ::: "memory")
#define WAIT_L(n) asm volatile("s_waitcnt lgkmcnt(" #n ")" ::: "memory")
#define BAR __builtin_amdgcn_s_barrier()
#define SCHED __builtin_amdgcn_sched_barrier(0)

  const int wid = swid, lane = lane_id_(), wr = wid >> 2, wc = wid & 3, fr = lane & 15, fq = lane >> 4;
  unsigned offA0, offA1, offB0, offB1;
  {
    int r0, c0, r1, c1;
    const int tb = (swid * 64 + lane) * 16;
    stage_rc(tb, r0, c0);
    stage_rc(tb + 8192, r1, c1);
    offA0 = (unsigned)(r0 * lda + c0) * 2u; offA1 = (unsigned)(r1 * lda + c1) * 2u;
    offB0 = (unsigned)(r0 * ldb + c0) * 2u; offB1 = (unsigned)(r1 * ldb + c1) * 2u;
  }
  const char* pa_lds = (const char*)smem + lds_byte(wr * 64 + fr, fq * 8);
  const char* pb_lds = (const char*)smem + lds_byte(wc * 32 + fr, fq * 8);
  f32x4 acc[2][2][4][2] = {};
  h16x8 At[4][2], B0[2][2], B1[2][2];
  const int nt = K / BK;
  STAGE_B(SB(0, 0), bcol, 0);
  STAGE_A(SA(0, 0), brow, 0);
  STAGE_B(SB(0, 1), bcol + HALF, 0);
  STAGE_A(SA(0, 1), brow + HALF, 0);
  if (wr == 1) BAR;
  WAIT_V(4);
  BAR;
  STAGE_B(SB(1, 0), bcol, 1);
  STAGE_A(SA(1, 0), brow, 1);
  STAGE_B(SB(1, 1), bcol + HALF, 1);
  WAIT_V(6);
  BAR;
  for (int t = 0; t < nt - 2; t += 2) {
    LDB(B0, 0, 0); SCHED; LDA(At, 0, 0); STAGE_A(SA(1, 1), brow + HALF, t + 1);
    WAIT_L(8); BAR; WAIT_L(0); MMA(0, 0, At, B0); BAR; SCHED;
    LDB(B1, 0, 1); STAGE_B(SB(0, 0), bcol, t + 2);
    BAR; WAIT_L(0); MMA(0, 1, At, B1); BAR;
    LDA(At, 0, 1); STAGE_A(SA(0, 0), brow, t + 2);
    BAR; WAIT_L(0); MMA(1, 0, At, B0); BAR; SCHED;
    STAGE_B(SB(0, 1), bcol + HALF, t + 2);
    WAIT_V(6); BAR; MMA(1, 1, At, B1); BAR;
    LDB(B0, 1, 0); SCHED; LDA(At, 1, 0); STAGE_A(SA(0, 1), brow + HALF, t + 2);
    WAIT_L(8); BAR; WAIT_L(0); MMA(0, 0, At, B0); BAR; SCHED;
    LDB(B1, 1, 1); STAGE_B(SB(1, 0), bcol, t + 3);
    BAR; WAIT_L(0); MMA(0, 1, At, B1); BAR;
    LDA(At, 1, 1); STAGE_A(SA(1, 0), brow, t + 3);
    BAR; WAIT_L(0); MMA(1, 0, At, B0); BAR; SCHED;
    STAGE_B(SB(1, 1), bcol + HALF, t + 3);
    WAIT_V(6); BAR; MMA(1, 1, At, B1); BAR;
  }
  {
    LDB(B0, 0, 0); LDA(At, 0, 0); STAGE_A(SA(1, 1), brow + HALF, nt - 1);
    BAR; WAIT_L(0); MMA(0, 0, At, B0); BAR;
    LDB(B1, 0, 1); BAR; WAIT_L(0); MMA(0, 1, At, B1); BAR;
    LDA(At, 0, 1); WAIT_V(4); BAR; WAIT_L(0); MMA(1, 0, At, B0); MMA(1, 1, At, B1); BAR;
  }
  {
    LDB(B0, 1, 0); LDA(At, 1, 0); WAIT_V(2); BAR; WAIT_L(0); MMA(0, 0, At, B0); BAR;
    LDB(B1, 1, 1); WAIT_V(0); BAR; WAIT_L(0); MMA(0, 1, At, B1); BAR;
    LDA(At, 1, 1); BAR; WAIT_L(0); MMA(1, 0, At, B0); MMA(1, 1, At, B1); BAR;
  }
  if (wr == 0) BAR;

  {
    float* cs = (float*)smem;
#pragma unroll
    for (int ai = 0; ai < 2; ++ai) {
#pragma unroll
      for (int bj = 0; bj < 2; ++bj)
#pragma unroll
        for (int m = 0; m < 4; ++m)
#pragma unroll
          for (int n = 0; n < 2; ++n)
#pragma unroll
            for (int j = 0; j < 4; ++j) {
              const int r = wr * 64 + m * 16 + fq * 4 + j;
              const int c = (bj * 128 + wc * 32 + n * 16 + fr) ^ (fq << 4);
              cs[r * 256 + c] = acc[ai][bj][m][n][j];
            }
      __syncthreads();
      epi_store<MODE>(swid, cs, brow + ai * HALF, bcol, e);
      __syncthreads();
    }
  }
#undef SA
#undef SB
#undef STAGE_A
#undef STAGE_B
#undef LDA
#undef LDB
#undef MMA
}

__device__ __forceinline__ bool tile_of(int step, int nM, int nN, int& pm, int& pn) {
  const int G = gridDim.x, b = blockIdx.x;
  const int ntiles = nM * nN, chunk = ntiles >> 3, nslots = G >> 3;
  const int xcd = b & 7, slot = b >> 3;
  const int L = step * nslots + slot;
  if (L >= chunk) return false;
  const int wgid = xcd * chunk + L;
  const int WGM = 4;
  const int nig = WGM * nN, gid = wgid / nig, fm = gid * WGM, gsz = min(nM - fm, WGM);
  pm = fm + ((wgid % nig) % gsz);
  pn = (wgid % nig) / gsz;
  return true;
}

struct ConvDesc { const float* src; h16* dst; };
__device__ __forceinline__ int conv_items(int layer) { return (layer & 1) ? (80 * 32 + 1024) : (84 * 32 + 1024); }
__device__ __forceinline__ ConvDesc conv_decode(const Params& p, int layer, int it, int& ldn) {
  h16* WT = (h16*)(p.ws + OFF_WT);
  h16* WO = (h16*)(p.ws + OFF_WO);
  const int il = layer >> 1;
  ConvDesc d;
  if (layer & 1) {
    if (it < 80 * 32) {
      int nt = it >> 5, kt = it & 31;
      ldn = 5120;
      d.src = p.odd_w_in + (size_t)il * 2048 * 5120 + (size_t)(kt * 64) * 5120 + nt * 64;
      d.dst = WT + (size_t)(nt * 64) * 2048 + kt * 64;
    } else {
      it -= 80 * 32;
      int nt = it >> 5, kt = it & 31;
      ldn = 2048;
      d.src = p.odd_w_out + (size_t)il * 2048 * 2048 + (size_t)(kt * 64) * 2048 + nt * 64;
      d.dst = WO + (size_t)(nt * 64) * 2048 + kt * 64;
    }
  } else {
    if (it < 84 * 32) {
      int nt = it >> 5, kt = it & 31;
      int srccol = nt * 64, dstrow = nt * 64;
      if (nt >= 68) { srccol = 5376 + (nt - 68) * 64; dstrow = 6400 + (nt - 68) * 64; }
      ldn = 6400;
      d.src = p.even_w_in + (size_t)il * 2048 * 6400 + (size_t)(kt * 64) * 6400 + srccol;
      d.dst = WT + (size_t)dstrow * 2048 + kt * 64;
    } else {
      it -= 84 * 32;
      int nt = it >> 5, kt = it & 31;
      ldn = 2048;
      d.src = p.even_w_out + (size_t)il * 2048 * 2048 + (size_t)(kt * 64) * 2048 + nt * 64;
      d.dst = WO + (size_t)(nt * 64) * 2048 + kt * 64;
    }
  }
  return d;
}
__device__ __forceinline__ void conv_run(const Params& p, const int swid, int layer, int first, int step, int count) {
  if (first >= count) return;
  float* tile = (float*)smem;
  const int tid = TIDX;
  const int kk = tid >> 4, n4 = tid & 15, nn = tid >> 3, kc = tid & 7;
  int ldn;
  ConvDesc d = conv_decode(p, layer, first, ldn);
  float4 r0 = *reinterpret_cast<const float4*>(d.src + (size_t)kk * ldn + n4 * 4);
  float4 r1 = *reinterpret_cast<const float4*>(d.src + (size_t)(kk + 32) * ldn + n4 * 4);
#pragma unroll 1
  for (int it = first; it < count; it += step) {
    ConvDesc dn = d;
    float4 q0 = r0, q1 = r1;
    if (it + step < count) {
      int ldn2;
      dn = conv_decode(p, layer, it + step, ldn2);
      q0 = *reinterpret_cast<const float4*>(dn.src + (size_t)kk * ldn2 + n4 * 4);
      q1 = *reinterpret_cast<const float4*>(dn.src + (size_t)(kk + 32) * ldn2 + n4 * 4);
    }
    tile[kk * 65 + n4 * 4 + 0] = r0.x; tile[kk * 65 + n4 * 4 + 1] = r0.y; tile[kk * 65 + n4 * 4 + 2] = r0.z; tile[kk * 65 + n4 * 4 + 3] = r0.w;
    tile[(kk + 32) * 65 + n4 * 4 + 0] = r1.x; tile[(kk + 32) * 65 + n4 * 4 + 1] = r1.y;
    tile[(kk + 32) * 65 + n4 * 4 + 2] = r1.z; tile[(kk + 32) * 65 + n4 * 4 + 3] = r1.w;
    __syncthreads();
    h16x8 o;
#pragma unroll
    for (int q = 0; q < 8; ++q) o[q] = (h16)tile[(kc * 8 + q) * 65 + nn];
    *reinterpret_cast<h16x8*>(d.dst + (size_t)nn * 2048 + kc * 8) = o;
    __syncthreads();
    d = dn; r0 = q0; r1 = q1;
  }
}

__device__ __forceinline__ void fold_tile(const Params& p, const int swid, int il, int tix) {
  const int pn = tix & 7, g = (tix >> 3) & 3, cs = tix >> 5;
  const h16* TWC = (const h16*)(p.ws + OFF_TWC) + (size_t)cs * 65536;
  const h16* WU = (const h16*)(p.ws + OFF_WU) + (size_t)il * 2048 * 1024 + g * 256;
  Epi e{};
  e.o0 = (h16*)(p.ws + OFF_WT) + (size_t)(4352 + cs * 1024 + g * 256) * 2048;
  gemm_tile<M_FOLD>(swid, TWC, TWC, 1 << 30, 256, WU, 1024, 256, 0, pn * 256, e);
}

__device__ __forceinline__ void phase0(const Params& p, const int swid) {
  const int G = gridDim.x, b = blockIdx.x, tid = TIDX;
  const int wid = tid >> 6, lane = tid & 63;
  if (b < 384) {
    float* sc = (float*)smem;
    float* part = (float*)(p.ws + OFF_PART);
    for (int it = b; it < 384; it += G) {
      const int l = it / 96, r = it % 96, kc = r / 12, cg = r % 12;
      __syncthreads();
      for (int i = tid; i < 9 * 256; i += NTHR) {
        const int c = i >> 8, k = kc * 256 + (i & 255);
        const float v = (c == 0) ? p.c_ctx[k] : p.c[(c - 1) * 2048 + k];
        sc[i] = siluf_(v);
      }
      __syncthreads();
      const int n = cg * 512 + tid;
      const float* W = p.mod_w + ((size_t)l * 2048 + kc * 256) * 6144 + n;
      float acc[9];
#pragma unroll
      for (int c = 0; c < 9; ++c) acc[c] = 0.f;
#pragma unroll 16
      for (int k = 0; k < 256; ++k) {
        const float w = W[(size_t)k * 6144];
#pragma unroll
        for (int c = 0; c < 9; ++c) acc[c] = fmaf(w, sc[c * 256 + k], acc[c]);
      }
      const float bias0 = (kc == 0) ? p.mod_b[(size_t)l * 6144 + n] : 0.f;
#pragma unroll
      for (int c = 0; c < 9; ++c) part[((size_t)(l * 8 + kc) * 9 + c) * 6144 + n] = acc[c] + bias0;
    }
    __syncthreads();
  }
  const int n_conv = conv_items(0);
  const int I_WU = n_conv, I_TWC = I_WU + 1024, I_TW2048 = I_TWC + 32, I_TW256 = I_TW2048 + 2048, I_ROPE = I_TW256 + 32,
            I_LW = I_ROPE + 1, I_CC = I_LW + 128, I_END = I_CC + 1024;
  conv_run(p, swid, 0, b, G, n_conv);
  for (int it = b; it < I_END; it += G) {
    if (it < n_conv) {
      continue;
    } else if (it < I_TWC) {
      int base = (it - I_WU) * 4096 + tid * 8;
      int il = base >> 21, rem = base & ((1 << 21) - 1), k = rem >> 10, c = rem & 1023;
      const float* s = p.even_w_in + ((size_t)il * 2048 + k) * 6400 + 4352 + c;
      float4 a = *reinterpret_cast<const float4*>(s), bb = *reinterpret_cast<const float4*>(s + 4);
      h16x8 o;
      o[0] = (h16)a.x; o[1] = (h16)a.y; o[2] = (h16)a.z; o[3] = (h16)a.w;
      o[4] = (h16)bb.x; o[5] = (h16)bb.y; o[6] = (h16)bb.z; o[7] = (h16)bb.w;
      *reinterpret_cast<h16x8*>((h16*)(p.ws + OFF_WU) + base) = o;
    } else if (it < I_TW2048) {
      int base = (it - I_TWC) * 4096 + tid * 8;
      int cs = base >> 16, f = (base >> 8) & 255, c0 = base & 255;
      h16x8 o;
#pragma unroll
      for (int q = 0; q < 8; ++q) {
        float x = (float)((f * (c0 + q)) & 255) * (1.f / 256.f);
        o[q] = (h16)(cs ? __builtin_amdgcn_sinf(x) : __builtin_amdgcn_cosf(x));
      }
      *reinterpret_cast<h16x8*>((h16*)(p.ws + OFF_TWC) + base) = o;
    } else if (it < I_TW256) {
      int base = (it - I_TW2048) * 4096 + tid * 8;
      int f = base >> 12, k0 = base & 4095;
      h16x8 o;
#pragma unroll
      for (int q = 0; q < 8; ++q) {
        int k = k0 + q;
        int sn = k >> 11, t = k & 2047;
        float x = (float)((f * t) & 2047) * (1.f / 2048.f);
        o[q] = (h16)(sn ? -__builtin_amdgcn_sinf(x) : __builtin_amdgcn_cosf(x));
      }
      *reinterpret_cast<h16x8*>((h16*)(p.ws + OFF_TW2048) + base) = o;
    } else if (it < I_ROPE) {
      int base = (it - I_TW256) * 4096 + tid * 8;
      int f = base >> 9, k0 = base & 511;
      h16x8 o;
#pragma unroll
      for (int q = 0; q < 8; ++q) {
        int k = k0 + q;
        int sn = k >> 8, t = k & 255;
        float x = (float)((f * t) & 255) * (1.f / 256.f);
        o[q] = (h16)(sn ? -__builtin_amdgcn_sinf(x) : __builtin_amdgcn_cosf(x));
      }
      *reinterpret_cast<h16x8*>((h16*)(p.ws + OFF_TW256) + base) = o;
    } else if (it < I_LW) {
      for (int i = tid; i < 1024; i += NTHR) {
        int pos = i >> 4, fi = i & 15;
        float inv = 1.0f / exp2f((float)fi * (13.287712379549449f / 16.f));
        float ang = (float)pos * inv;
        float x = ang * 0.15915494309189535f;
        x = x - floorf(x);
        ((float*)(p.ws + OFF_ROPE))[i * 2] = __builtin_amdgcn_cosf(x);
        ((float*)(p.ws + OFF_ROPE))[i * 2 + 1] = __builtin_amdgcn_sinf(x);
      }
    } else if (it >= I_CC) {
      int base = (it - I_CC) * 4096 + tid * 8;
      int which = base >= (int)CACHE_ELEMS;
      int off = base - which * (int)CACHE_ELEMS;
      const float* src = (which ? p.cache_v : p.cache_k) + off;
      float4 a = *reinterpret_cast<const float4*>(src), bb = *reinterpret_cast<const float4*>(src + 4);
      h16x8 o;
      o[0] = (h16)a.x; o[1] = (h16)a.y; o[2] = (h16)a.z; o[3] = (h16)a.w;
      o[4] = (h16)bb.x; o[5] = (h16)bb.y; o[6] = (h16)bb.z; o[7] = (h16)bb.w;
      *reinterpret_cast<h16x8*>((h16*)(p.ws + (which ? OFF_CV : OFF_CK)) + off) = o;
    } else {
      int ti = (it - I_LW) * 512 + tid;
      int kc = ti & 7, n = (ti >> 3) & 1023, combo = ti >> 13;
      int il = combo >> 2, type = (combo >> 1) & 1, dir = combo & 1;
      const float* src = (type ? p.even_a_up : p.even_w_up) + ((size_t)(il * 2 + dir) * 64 + kc * 8) * 1024 + n;
      h16x8 o;
#pragma unroll
      for (int q = 0; q < 8; ++q) o[q] = (h16)src[(size_t)q * 1024];
      *reinterpret_cast<h16x8*>((h16*)(p.ws + OFF_LW) + ((size_t)combo * 1024 + n) * 64 + kc * 8) = o;
    }
  }
}

__device__ __forceinline__ void norm_rows(const Params& p, const int swid, int l_done, int l_next) {
  const int tid = TIDX, wid = tid >> 6, lane = tid & 63;
  const float* mod = (const float*)(p.ws + OFF_PART);
  const h16* yout = (const h16*)(p.ws + OFF_C);
  h16* H = (h16*)(p.ws + OFF_H);
  const bool has_y = l_done >= 0, has_h = l_next < 4;
  float* par = (float*)smem;
  const int brow0 = blockIdx.x * 96;
  auto cond_of = [&](int row) -> int { return (row < NPR) ? 0 : 1 + ((row - NPR) >> 11); };
  const int c_first = cond_of(brow0), c_last = cond_of(brow0 + 95);
  __syncthreads();
  const int nset = (c_last != c_first) ? 2 : 1;
  for (int i = tid; i < nset * 2048; i += NTHR) {
    const int set = i >> 11, col = i & 2047;
    const int c = set ? c_last : c_first;
    float v1 = 0.f, v2 = 0.f, v3 = 0.f;
    auto mod_get = [&](int l, int idx) -> float {
      float sum = 0.f;
#pragma unroll
      for (int kc = 0; kc < 8; ++kc) sum += mod[((size_t)(l * 8 + kc) * 9 + c) * 6144 + idx];
      return sum;
    };
    if (has_y) v1 = mod_get(l_done, 4096 + col) * p.norm_post[(size_t)l_done * 2048 + col];
    if (has_h) {
      v2 = p.norm_pre[(size_t)l_next * 2048 + col] * (1.f + mod_get(l_next, 2048 + col));
      v3 = mod_get(l_next, col);
    }
    par[(set * 3 + 0) * 2048 + col] = v1;
    par[(set * 3 + 1) * 2048 + col] = v2;
    par[(set * 3 + 2) * 2048 + col] = v3;
  }
  __syncthreads();
  const int rbase = brow0 + wid * 12;
  auto row_ptr = [&](int row) -> const float* {
    if (l_done <= 0) return (row < NPR) ? (p.x_prompt + (size_t)row * 2048) : (p.x_sample + (size_t)(row - NPR) * 2048);
    return p.out + (size_t)row * 2048;
  };
  struct RowBuf { float4 x[8]; h16x4 y[8]; };
  auto load_row = [&](int row, RowBuf& rb) {
    const float* xin = row_ptr(row);
#pragma unroll
    for (int i = 0; i < 8; ++i) rb.x[i] = *reinterpret_cast<const float4*>(xin + i * 256 + lane * 4);
    if (has_y) {
#pragma unroll
      for (int i = 0; i < 8; ++i) rb.y[i] = *reinterpret_cast<const h16x4*>(yout + (size_t)row * 2048 + i * 256 + lane * 4);
    }
  };
  auto process = [&](int row, RowBuf& rb) {
    const float* ps = par + ((cond_of(row) == c_first) ? 0 : 3 * 2048) + lane * 4;
    if (has_y) {
      float ss = 0.f;
#pragma unroll
      for (int i = 0; i < 8; ++i)
#pragma unroll
        for (int e = 0; e < 4; ++e) { const float yv = (float)rb.y[i][e]; ss += yv * yv; }
      ss = wave_sum(ss);
      const float rstd = rsqrtf(ss * (1.f / 2048.f) + 1e-6f);
#pragma unroll
      for (int i = 0; i < 8; ++i) {
        const float4 q1 = *reinterpret_cast<const float4*>(ps + i * 256);
        rb.x[i].x += q1.x * ((float)rb.y[i][0] * rstd);
        rb.x[i].y += q1.y * ((float)rb.y[i][1] * rstd);
        rb.x[i].z += q1.z * ((float)rb.y[i][2] * rstd);
        rb.x[i].w += q1.w * ((float)rb.y[i][3] * rstd);
        *reinterpret_cast<float4*>(p.out + (size_t)row * 2048 + i * 256 + lane * 4) = rb.x[i];
      }
    }
    if (has_h) {
      float ss = 0.f;
#pragma unroll
      for (int i = 0; i < 8; ++i) ss += rb.x[i].x * rb.x[i].x + rb.x[i].y * rb.x[i].y + rb.x[i].z * rb.x[i].z + rb.x[i].w * rb.x[i].w;
      ss = wave_sum(ss);
      const float rstd = rsqrtf(ss * (1.f / 2048.f) + 1e-6f);
#pragma unroll
      for (int i = 0; i < 8; ++i) {
        const float4 q2 = *reinterpret_cast<const float4*>(ps + 2048 + i * 256);
        const float4 q3 = *reinterpret_cast<const float4*>(ps + 4096 + i * 256);
        h16x4 o;
        o[0] = (h16)(rb.x[i].x * rstd * q2.x + q3.x);
        o[1] = (h16)(rb.x[i].y * rstd * q2.y + q3.y);
        o[2] = (h16)(rb.x[i].z * rstd * q2.z + q3.z);
        o[3] = (h16)(rb.x[i].w * rstd * q2.w + q3.w);
        *reinterpret_cast<h16x4*>(H + (size_t)row * 2048 + i * 256 + lane * 4) = o;
      }
    }
  };
  RowBuf A, B;
  load_row(rbase, A);
#pragma unroll 1
  for (int k = 0; k < 12; k += 2) {
    load_row(rbase + k + 1, B);
    process(rbase + k, A);
    if (k + 2 < 12) load_row(rbase + k + 2, A);
    process(rbase + k + 1, B);
  }
  __syncthreads();
}

__device__ __forceinline__ void even_prep(const Params& p, const int swid, int il) {
  const int tid = TIDX, wid = tid >> 6, lane = tid & 63;
  const h16* PA = (const h16*)(p.ws + OFF_PA);
  h16* RS = (h16*)(p.ws + OFF_H);
  h16* KS = RS + NT1K;
  h16* Cb = (h16*)(p.ws + OFF_C);
  h16* VS = Cb + 4 * NT1K;
  float* RN = (float*)(p.ws + OFF_RN);
  const float* mu = p.even_mu + (size_t)il * 3328;
  const float* kkw = p.even_k_k + (size_t)il * 1024;
  h16* Alow = (h16*)smem;
  const int LDL = 264;
  const h16* LW = (const h16*)(p.ws + OFF_LW) + (size_t)il * 4 * 1024 * 64;
  for (int item = blockIdx.x; item < NT / 32; item += gridDim.x) {
    const int row0 = item * 32;
    {
      const int rbase = row0 + wid * 4;
      int T, t0;
      if (rbase < NPR) { T = 256; t0 = rbase & 255; } else { T = 2048; t0 = (rbase - NPR) & 2047; }
      const bool has_m1 = t0 > 0, has_p4 = (t0 + 4) < T;
      const h16* base = PA + (size_t)rbase * 3328;
      struct RowsIn { h16x8 x[6]; float4 m0, m1, k0, k1; };
      auto load_rows = [&](int ch, RowsIn& in) {
        const int c0 = ch * 8;
        in.x[0] = h16x8{}; in.x[5] = h16x8{};
        if (has_m1) in.x[0] = *reinterpret_cast<const h16x8*>(base - 3328 + c0);
#pragma unroll
        for (int i = 0; i < 4; ++i) in.x[i + 1] = *reinterpret_cast<const h16x8*>(base + (size_t)i * 3328 + c0);
        if (has_p4) in.x[5] = *reinterpret_cast<const h16x8*>(base + (size_t)4 * 3328 + c0);
        in.m0 = *reinterpret_cast<const float4*>(mu + c0);
        in.m1 = *reinterpret_cast<const float4*>(mu + c0 + 4);
        in.k0 = float4{0.f, 0.f, 0.f, 0.f}; in.k1 = in.k0;
        if (c0 >= 1024 && c0 < 2048) {
          in.k0 = *reinterpret_cast<const float4*>(kkw + c0 - 1024);
          in.k1 = *reinterpret_cast<const float4*>(kkw + c0 - 1020);
        }
      };
      auto compute = [&](int ch, const RowsIn& in) {
        const int c0 = ch * 8;
        const float mm[8] = {in.m0.x, in.m0.y, in.m0.z, in.m0.w, in.m1.x, in.m1.y, in.m1.z, in.m1.w};
        const float kq[8] = {in.k0.x, in.k0.y, in.k0.z, in.k0.w, in.k1.x, in.k1.y, in.k1.z, in.k1.w};
#pragma unroll
        for (int tt = 0; tt < 4; ++tt) {
          const int row = rbase + tt;
          float sv[8];
#pragma unroll
          for (int q = 0; q < 8; ++q) {
            float xcq = (float)in.x[tt + 1][q];
            sv[q] = xcq + mm[q] * (0.5f * ((float)in.x[tt][q] + (float)in.x[tt + 2][q]) - xcq);
          }
          if (c0 < 3072) {
            h16x8 o;
#pragma unroll
            for (int q = 0; q < 8; ++q) o[q] = (h16)sv[q];
            if (c0 < 1024) *reinterpret_cast<h16x8*>(RS + (size_t)row * 1024 + c0) = o;
            else if (c0 < 2048) {
              *reinterpret_cast<h16x8*>(KS + (size_t)row * 1024 + (c0 - 1024)) = o;
              float ssq = 0.f;
#pragma unroll
              for (int q = 0; q < 8; ++q) { float v = (float)o[q] * kq[q]; ssq += v * v; }
              ssq += __shfl_xor(ssq, 1);
              ssq += __shfl_xor(ssq, 2);
              ssq += __shfl_xor(ssq, 4);
              if ((lane & 7) == 0) RN[(size_t)row * 16 + ((c0 - 1024) >> 6)] = 1.f / fmaxf(sqrtf(ssq), 1e-12f);
            } else *reinterpret_cast<h16x8*>(VS + (size_t)row * 1024 + (c0 - 2048)) = o;
          } else {
            const int lc = c0 - 3072;
            h16x8 o;
#pragma unroll
            for (int q = 0; q < 8; ++q) o[q] = (h16)((lc < 128) ? tanhf(sv[q]) : sv[q]);
            *reinterpret_cast<h16x8*>(Alow + (wid * 4 + tt) * LDL + lc) = o;
          }
        }
      };
      RowsIn ra, rb;
      load_rows(lane, ra);
#pragma unroll 1
      for (int i = 0; i < 6; i += 2) {
        load_rows(lane + 64 * (i + 1), rb);
        compute(lane + 64 * i, ra);
        if (i + 2 < 6 || lane < 32) load_rows(lane + 64 * (i + 2), ra);
        compute(lane + 64 * (i + 1), rb);
      }
      if (lane < 32) compute(lane + 64 * 6, ra);
    }
    __syncthreads();
    {
      const int fr = lane & 15, fq = lane >> 4;
#pragma unroll 1
      for (int combo = 0; combo < 4; ++combo) {
        const int type = combo >> 1, dir = combo & 1;
        h16x8 af[2][2];
#pragma unroll
        for (int m = 0; m < 2; ++m)
#pragma unroll
          for (int ks = 0; ks < 2; ++ks)
            af[m][ks] = *reinterpret_cast<const h16x8*>(Alow + (m * 16 + fr) * LDL + type * 128 + dir * 64 + ks * 32 + fq * 8);
        const float* bias = (type ? p.even_a0 : p.even_w0) + (size_t)(il * 2 + dir) * 1024;
        h16* dst = Cb + (size_t)(type * 2 + dir) * NT1K;
#pragma unroll 1
        for (int nti = 0; nti < 8; ++nti) {
          const int n0 = (wid * 8 + nti) * 16;
          const h16* lw = LW + ((size_t)combo * 1024 + n0 + fr) * 64 + fq * 8;
          h16x8 b0 = *reinterpret_cast<const h16x8*>(lw), b1 = *reinterpret_cast<const h16x8*>(lw + 32);
          const float bs = bias[n0 + fr];
#pragma unroll
          for (int m = 0; m < 2; ++m) {
            f32x4 acc = {0.f, 0.f, 0.f, 0.f};
            acc = __builtin_amdgcn_mfma_f32_16x16x32_f16(af[m][0], b0, acc, 0, 0, 0);
            acc = __builtin_amdgcn_mfma_f32_16x16x32_f16(af[m][1], b1, acc, 0, 0, 0);
#pragma unroll
            for (int j = 0; j < 4; ++j) {
              float v = acc[j] + bs;
              float o = type ? sigmoidf_(v) : __expf(-0.6065306597126334f * sigmoidf_(v));
              dst[(size_t)(row0 + m * 16 + fq * 4 + j) * 1024 + n0 + fr] = (h16)o;
            }
          }
        }
      }
    }
    __syncthreads();
  }
}

template <int CTRL>
__device__ __forceinline__ float dpp_f(float v) {
  return __builtin_bit_cast(float, __builtin_amdgcn_update_dpp(0, __builtin_bit_cast(int, v), CTRL, 0xF, 0xF, true));
}
__device__ __forceinline__ float red8(float v) {
  v += dpp_f<0xB1>(v);
  v += dpp_f<0x4E>(v);
  v += dpp_f<0x141>(v);
  return v;
}
__device__ __forceinline__ void red8x2(float& a, float& b) {
  asm volatile(
      "s_nop 1\n\t"
      "v_add_f32_dpp %0, %0, %0 quad_perm:[1,0,3,2] row_mask:0xf bank_mask:0xf\n\t"
      "v_add_f32_dpp %1, %1, %1 quad_perm:[1,0,3,2] row_mask:0xf bank_mask:0xf\n\t"
      "s_nop 0\n\t"
      "v_add_f32_dpp %0, %0, %0 quad_perm:[2,3,0,1] row_mask:0xf bank_mask:0xf\n\t"
      "v_add_f32_dpp %1, %1, %1 quad_perm:[2,3,0,1] row_mask:0xf bank_mask:0xf\n\t"
      "s_nop 0\n\t"
      "v_add_f32_dpp %0, %0, %0 row_half_mirror row_mask:0xf bank_mask:0xf\n\t"
      "v_add_f32_dpp %1, %1, %1 row_half_mirror row_mask:0xf bank_mask:0xf\n\t"
      : "+v"(a), "+v"(b));
}

typedef __attribute__((ext_vector_type(2))) _Float16 h16x2;
constexpr int CS = 16;
constexpr int SC_RAW = 5 * CS * 128 + 256;
constexpr int SC_F32 = 6 * CS * 256;
constexpr int SC_TEAM = 2 * SC_RAW + 2 * SC_F32;

__device__ __forceinline__ void even_scan(const Params& p, const int swid, int il) {
  const int lane = lane_id_(), wid = swid;
  const int team = wid >> 2, part = wid & 3;
  const int bi = lane >> 3, bj = lane & 7;
  const int blk = blockIdx.x;
  const h16* RS = (const h16*)(p.ws + OFF_H);
  const h16* Cb = (const h16*)(p.ws + OFF_C);
  const float* RN = (const float*)(p.ws + OFF_RN);
  h16* Ob = (h16*)(p.ws + OFF_PA);
  char* traw = smem + team * SC_TEAM;
  char* tf32 = traw + 2 * SC_RAW;
  const int i0 = part * 16 + bi * 2, j0 = bj * 8;
  const int NIT = 2048 / CS;

  auto unit_of = [&](int it, int& T, int& rowbase, int& bidx, int& h, int& dir, int& chunk) -> bool {
    int unit;
    if (it >= NIT) return false;
    if (team == 0) { unit = blk; T = 2048; chunk = it; }
    else { if (it >= 4 * (256 / CS)) return false; unit = blk * 4 + it / (256 / CS); T = 256; chunk = it % (256 / CS); }
    dir = unit & 1; h = (unit >> 1) & 15; bidx = unit >> 5;
    rowbase = (team == 0) ? (NPR + bidx * 2048) : (bidx * 256);
    return true;
  };
  auto issue_chunk = [&](int it) {
    int T, rowbase, bidx, h, dir, chunk;
    if (!unit_of(it, T, rowbase, bidx, h, dir, chunk)) return;
    char* buf = traw + (it & 1) * SC_RAW;
    const int row0 = rowbase + (dir ? (T - CS - chunk * CS) : (chunk * CS));
#pragma unroll
    for (int m = 0; m < 3; ++m) {
      const int idx = part + 4 * m;
      if (idx < 5 * (CS / 8)) {
        const int arr = idx / (CS / 8), half = idx % (CS / 8);
        const h16* base = (arr == 0) ? RS : (arr == 1) ? (RS + NT1K) : (arr == 2) ? (Cb + (size_t)dir * NT1K)
                          : (arr == 3) ? (Cb + (size_t)(2 + dir) * NT1K) : (Cb + 4 * NT1K);
        const h16* src = base + (size_t)(row0 + half * 8 + (lane >> 3)) * 1024 + h * 64 + (lane & 7) * 8;
        __builtin_amdgcn_global_load_lds((const unsigned*)src, (unsigned*)(buf + arr * (CS * 128) + half * 1024), 16, 0, 0);
      } else if (idx == 5 * (CS / 8)) {
        const int r = lane < CS ? lane : CS - 1;
        const float* src = RN + (size_t)(row0 + r) * 16 + h;
        __builtin_amdgcn_global_load_lds((const unsigned*)src, (unsigned*)(buf + 5 * CS * 128), 4, 0, 0);
      }
    }
  };
  float kkc0 = 0.f, kkc1 = 0.f, kac0 = 0.f, kac1 = 0.f;
  auto prep_chunk = [&](int it) {
    int T, rowbase, bidx, h, dir, chunk;
    if (!unit_of(it, T, rowbase, bidx, h, dir, chunk)) return;
    const int sp = lane >> 5, cp = lane & 31;
    if (chunk == 0) {
      const float2 a = *reinterpret_cast<const float2*>(p.even_k_k + (size_t)il * 1024 + h * 64 + cp * 2);
      const float2 c = *reinterpret_cast<const float2*>(p.even_k_a + (size_t)il * 1024 + h * 64 + cp * 2);
      kkc0 = a.x; kkc1 = a.y; kac0 = c.x; kac1 = c.y;
      asm volatile("s_waitcnt vmcnt(0)" ::: "memory");
      asm volatile("" : "+v"(kkc0), "+v"(kkc1), "+v"(kac0), "+v"(kac1));
    }
    const char* raw = traw + (it & 1) * SC_RAW;
    char* f = tf32 + (it & 1) * SC_F32;
#pragma unroll
    for (int pass = 0; pass < CS / 8; ++pass) {
      const int s = (CS / 4) * part + 2 * pass + sp;
      const int r = dir ? (CS - 1 - s) : s;
      const h16x2 r2 = *reinterpret_cast<const h16x2*>(raw + r * 128 + cp * 4);
      const h16x2 k2 = *reinterpret_cast<const h16x2*>(raw + CS * 128 + r * 128 + cp * 4);
      const h16x2 w2 = *reinterpret_cast<const h16x2*>(raw + 2 * CS * 128 + r * 128 + cp * 4);
      const h16x2 a2 = *reinterpret_cast<const h16x2*>(raw + 3 * CS * 128 + r * 128 + cp * 4);
      const h16x2 v2 = *reinterpret_cast<const h16x2*>(raw + 4 * CS * 128 + r * 128 + cp * 4);
      const float rn = *reinterpret_cast<const float*>(raw + 5 * CS * 128 + r * 4);
      const float kf0 = (float)k2[0], kf1 = (float)k2[1], af0 = (float)a2[0], af1 = (float)a2[1];
      float2 kk, kka, kd, rr, ww, vv;
      kk.x = kf0 * (kkc0 * rn); kk.y = kf1 * (kkc1 * rn);
      kka.x = kk.x * af0; kka.y = kk.y * af1;
      kd.x = kf0 * fmaf(af0 - 1.f, kac0, 1.f); kd.y = kf1 * fmaf(af1 - 1.f, kac1, 1.f);
      rr.x = (float)r2[0]; rr.y = (float)r2[1];
      ww.x = (float)w2[0]; ww.y = (float)w2[1];
      vv.x = (float)v2[0]; vv.y = (float)v2[1];
      char* fo = f + s * 256 + cp * 8;
      *reinterpret_cast<float2*>(fo) = kk;
      *reinterpret_cast<float2*>(fo + CS * 256) = kka;
      *reinterpret_cast<float2*>(fo + 2 * CS * 256) = kd;
      *reinterpret_cast<float2*>(fo + 3 * CS * 256) = rr;
      *reinterpret_cast<float2*>(fo + 4 * CS * 256) = ww;
      *reinterpret_cast<float2*>(fo + 5 * CS * 256) = vv;
    }
  };

  f32x2 S2[2][4];
#pragma unroll
  for (int q = 0; q < 4; ++q) { S2[0][q] = f32x2{0.f, 0.f}; S2[1][q] = f32x2{0.f, 0.f}; }

  issue_chunk(0);
  issue_chunk(1);
  asm volatile("s_waitcnt vmcnt(0)" ::: "memory");
  __syncthreads();
  prep_chunk(0);
  __syncthreads();
#pragma unroll 1
  for (int it = 0; it < NIT; ++it) {
    issue_chunk(it + 2);
    prep_chunk(it + 1);
    int T, rowbase, bidx, h, dir, chunk;
    if (unit_of(it, T, rowbase, bidx, h, dir, chunk)) {
      const int ci = h * 64 + i0;
      if (chunk == 0) {
        if (team == 0) {
          const float* st = p.state_wkv + ((((size_t)bidx * 2 + il) * 2 + dir) * 16 + h) * 4096;
#pragma unroll
          for (int a2 = 0; a2 < 2; ++a2) {
            float4 s0 = *reinterpret_cast<const float4*>(st + (size_t)(i0 + a2) * 64 + j0);
            float4 s1 = *reinterpret_cast<const float4*>(st + (size_t)(i0 + a2) * 64 + j0 + 4);
            S2[a2][0] = f32x2{s0.x, s0.y}; S2[a2][1] = f32x2{s0.z, s0.w};
            S2[a2][2] = f32x2{s1.x, s1.y}; S2[a2][3] = f32x2{s1.z, s1.w};
          }
          asm volatile("s_waitcnt vmcnt(0)" ::: "memory");
#pragma unroll
          for (int q = 0; q < 4; ++q) asm volatile("" : "+v"(S2[0][q]), "+v"(S2[1][q]));
        } else {
#pragma unroll
          for (int q = 0; q < 4; ++q) { S2[0][q] = f32x2{0.f, 0.f}; S2[1][q] = f32x2{0.f, 0.f}; }
        }
      }
      const char* f = tf32 + (it & 1) * SC_F32 + j0 * 4;
      const char* fv = tf32 + (it & 1) * SC_F32 + 5 * CS * 256 + i0 * 4;
      const int row0 = rowbase + (dir ? (T - CS - chunk * CS) : (chunk * CS));
      h16* Od = Ob + (size_t)dir * NT1K + (size_t)row0 * 1024 + ci;
      const int rstart = dir ? CS - 1 : 0, rstep = dir ? -1 : 1;
      struct FIn { float4 q[10]; float2 v; };
      auto ldstep = [&](int s) -> FIn {
        FIn in;
        const float4* q0 = reinterpret_cast<const float4*>(f + s * 256);
        constexpr int VS16 = CS * 16;
        in.q[0] = q0[0]; in.q[1] = q0[1]; in.q[2] = q0[VS16]; in.q[3] = q0[VS16 + 1]; in.q[4] = q0[2 * VS16]; in.q[5] = q0[2 * VS16 + 1];
        in.q[6] = q0[3 * VS16]; in.q[7] = q0[3 * VS16 + 1]; in.q[8] = q0[4 * VS16]; in.q[9] = q0[4 * VS16 + 1];
        in.v = *reinterpret_cast<const float2*>(fv + s * 256);
        return in;
      };
      FIn cur = ldstep(0);
#pragma unroll
      for (int s = 0; s < CS; ++s) {
        FIn nxt = ldstep(s < CS - 1 ? s + 1 : CS - 1);
        f32x2 kk[4], kka[4], kd[4], rv[4], wv[4];
#pragma unroll
        for (int h2 = 0; h2 < 2; ++h2) {
          float4 t;
          t = cur.q[0 + h2]; kk[2 * h2] = f32x2{t.x, t.y}; kk[2 * h2 + 1] = f32x2{t.z, t.w};
          t = cur.q[2 + h2]; kka[2 * h2] = f32x2{t.x, t.y}; kka[2 * h2 + 1] = f32x2{t.z, t.w};
          t = cur.q[4 + h2]; kd[2 * h2] = f32x2{t.x, t.y}; kd[2 * h2 + 1] = f32x2{t.z, t.w};
          t = cur.q[6 + h2]; rv[2 * h2] = f32x2{t.x, t.y}; rv[2 * h2 + 1] = f32x2{t.z, t.w};
          t = cur.q[8 + h2]; wv[2 * h2] = f32x2{t.x, t.y}; wv[2 * h2 + 1] = f32x2{t.z, t.w};
        }
        const float2 vin = cur.v;
        float sa[2];
#pragma unroll
        for (int a2 = 0; a2 < 2; ++a2) {
          f32x2 t = S2[a2][0] * kk[0];
          t += S2[a2][1] * kk[1];
          t += S2[a2][2] * kk[2];
          t += S2[a2][3] * kk[3];
          sa[a2] = t[0] + t[1];
        }
        red8x2(sa[0], sa[1]);
        float o[2];
#pragma unroll
        for (int a2 = 0; a2 < 2; ++a2) {
          const float va = a2 ? vin.y : vin.x;
          const float nsa = -sa[a2];
          f32x2 t;
#pragma unroll
          for (int q = 0; q < 4; ++q) {
            f32x2 u = kd[q] * va + kka[q] * nsa;
            S2[a2][q] = S2[a2][q] * wv[q] + u;
            if (q == 0) t = S2[a2][q] * rv[q]; else t += S2[a2][q] * rv[q];
          }
          o[a2] = t[0] + t[1];
        }
        red8x2(o[0], o[1]);
        if (bj == 0) {
          h16x2 ov;
          ov[0] = (h16)o[0]; ov[1] = (h16)o[1];
          *reinterpret_cast<h16x2*>(Od + (size_t)(rstart + rstep * s) * 1024) = ov;
        }
        cur = nxt;
      }
      if (team == 1 && chunk == 256 / CS - 1) {
        float* so = p.out + OUT_STATE + ((((size_t)bidx * 2 + il) * 2 + dir) * 16 + h) * 4096;
#pragma unroll
        for (int a2 = 0; a2 < 2; ++a2) {
          float4 s0 = {S2[a2][0][0], S2[a2][0][1], S2[a2][1][0], S2[a2][1][1]};
          float4 s1 = {S2[a2][2][0], S2[a2][2][1], S2[a2][3][0], S2[a2][3][1]};
          *reinterpret_cast<float4*>(so + (size_t)(i0 + a2) * 64 + j0) = s0;
          *reinterpret_cast<float4*>(so + (size_t)(i0 + a2) * 64 + j0 + 4) = s1;
        }
      }
    }
    asm volatile("s_waitcnt vmcnt(16) lgkmcnt(0)" ::: "memory");
    __builtin_amdgcn_s_barrier();
    asm volatile("" ::: "memory");
  }
}

__device__ __forceinline__ void even_post(const Params& p, const int swid, int il) {
  const int tid = TIDX, wid = tid >> 6, lane = tid & 63;
  const h16* RS = (const h16*)(p.ws + OFF_H);
  const h16* KS = RS + NT1K;
  const h16* Cb = (const h16*)(p.ws + OFF_C);
  const h16* AF = Cb + 2 * NT1K;
  const h16* AB = Cb + 3 * NT1K;
  const h16* VS = Cb + 4 * NT1K;
  const h16* OF = (const h16*)(p.ws + OFF_PA);
  const h16* OB = OF + NT1K;
  h16* GA = (h16*)(p.ws + OFF_PB);
  const int c0 = (lane >> 2) * 64 + (lane & 3) * 16;
  float ka[16], rk[16], gw[16], gb[16];
#pragma unroll
  for (int q = 0; q < 4; ++q) {
    float4 t;
    t = *reinterpret_cast<const float4*>(p.even_k_a + (size_t)il * 1024 + c0 + q * 4); ka[q * 4] = t.x; ka[q * 4 + 1] = t.y; ka[q * 4 + 2] = t.z; ka[q * 4 + 3] = t.w;
    t = *reinterpret_cast<const float4*>(p.even_r_k + (size_t)il * 1024 + c0 + q * 4); rk[q * 4] = t.x; rk[q * 4 + 1] = t.y; rk[q * 4 + 2] = t.z; rk[q * 4 + 3] = t.w;
    t = *reinterpret_cast<const float4*>(p.even_gn_w + (size_t)il * 1024 + c0 + q * 4); gw[q * 4] = t.x; gw[q * 4 + 1] = t.y; gw[q * 4 + 2] = t.z; gw[q * 4 + 3] = t.w;
    t = *reinterpret_cast<const float4*>(p.even_gn_b + (size_t)il * 1024 + c0 + q * 4); gb[q * 4] = t.x; gb[q * 4 + 1] = t.y; gb[q * 4 + 2] = t.z; gb[q * 4 + 3] = t.w;
  }
#pragma unroll 1
  for (int row = blockIdx.x * 8 + wid; row < NT; row += gridDim.x * 8) {
    const size_t idx = (size_t)row * 1024 + c0;
    h16x8 of[2], ob[2], rs[2], ks[2], vs[2], af[2], ab[2], ga[2];
#pragma unroll
    for (int hh = 0; hh < 2; ++hh) {
      of[hh] = *reinterpret_cast<const h16x8*>(OF + idx + hh * 8);
      ob[hh] = *reinterpret_cast<const h16x8*>(OB + idx + hh * 8);
      rs[hh] = *reinterpret_cast<const h16x8*>(RS + idx + hh * 8);
      ks[hh] = *reinterpret_cast<const h16x8*>(KS + idx + hh * 8);
      vs[hh] = *reinterpret_cast<const h16x8*>(VS + idx + hh * 8);
      af[hh] = *reinterpret_cast<const h16x8*>(AF + idx + hh * 8);
      ab[hh] = *reinterpret_cast<const h16x8*>(AB + idx + hh * 8);
      ga[hh] = *reinterpret_cast<const h16x8*>(GA + idx + hh * 8);
    }
    float o[16];
    float s1 = 0.f, bon = 0.f;
#pragma unroll
    for (int q = 0; q < 16; ++q) {
      const int hh = q >> 3, e = q & 7;
      o[q] = (float)of[hh][e] + (float)ob[hh][e];
      s1 += o[q];
      const float am = 0.5f * ((float)af[hh][e] + (float)ab[hh][e]);
      bon += (float)rs[hh][e] * ((float)ks[hh][e] * (1.f + (am - 1.f) * ka[q])) * rk[q];
    }
    s1 += __shfl_xor(s1, 1); s1 += __shfl_xor(s1, 2);
    bon += __shfl_xor(bon, 1); bon += __shfl_xor(bon, 2);
    const float mean = s1 * (1.f / 64.f);
    float s2 = 0.f;
#pragma unroll
    for (int q = 0; q < 16; ++q) { o[q] -= mean; s2 += o[q] * o[q]; }
    s2 += __shfl_xor(s2, 1); s2 += __shfl_xor(s2, 2);
    const float rstd = rsqrtf(s2 * (1.f / 64.f) + 64e-5f);
    h16x8 out[2];
#pragma unroll
    for (int q = 0; q < 16; ++q) {
      const int hh = q >> 3, e = q & 7;
      const float gn = o[q] * rstd * gw[q] + gb[q];
      out[hh][e] = (h16)((gn + bon * (float)vs[hh][e]) * siluf_((float)ga[hh][e]));
    }
    *reinterpret_cast<h16x8*>(GA + idx) = out[0];
    *reinterpret_cast<h16x8*>(GA + idx + 8) = out[1];
  }
}

__device__ __forceinline__ void dft2_tiles(const Params& p, const int swid) {
  const h16* UT = (const h16*)(p.ws + OFF_PB) + NT1K;
  h16* GB = (h16*)(p.ws + OFF_PB) + NT1K + (size_t)NT * 2048;
  for (int it = blockIdx.x; it < 384; it += gridDim.x) {
    Epi e{};
    if (it < 256) {
      int mt = it & 7, g = (it >> 3) & 3, b = it >> 5;
      const h16* A = (const h16*)(p.ws + OFF_TW2048);
      const h16* Bt = UT + (size_t)16777216 + (size_t)b * 4194304 + (size_t)g * 256 * 4096;
      e.o0 = GB + (size_t)(NPR + b * 2048) * 1024;
      e.aux = g * 256;
      e.scale = 0.001381067932004975f;
      gemm_tile<M_DFT2>(swid, A, A, 1 << 30, 4096, Bt, 4096, 4096, mt * 256, 0, e);
    } else {
      int i2 = it - 256;
      int g = i2 & 3, b = i2 >> 2;
      const h16* A = (const h16*)(p.ws + OFF_TW256);
      const h16* Bt = UT + (size_t)b * 524288 + (size_t)g * 256 * 512;
      e.o0 = GB + (size_t)(b * 256) * 1024;
      e.aux = g * 256;
      e.scale = 0.00390625f;
      gemm_tile<M_DFT2>(swid, A, A, 1 << 30, 512, Bt, 512, 512, 0, 0, e);
    }
  }
}

__device__ __forceinline__ void attention(const Params& p, const int swid, int il) {
  const int tid = TIDX, wid = swid, lane = tid & 63;
  const int fr = lane & 15, fq = lane >> 4;
  const h16* Q = (const h16*)(p.ws + OFF_PA);
  const h16* KB = (const h16*)(p.ws + OFF_PB);
  const h16* VB = KB + (size_t)NT * 512;
  const h16* GT = KB + NT1K;
  h16* Y = (h16*)(p.ws + OFF_H);
  h16* Ks = (h16*)smem;
  h16* Vt = Ks + 128 * 72;
  h16* Qs = Vt + 64 * 136;
  constexpr int LDK = 72, LDV = 136;
  if (swid >= 4) __builtin_amdgcn_s_setprio(1);
#pragma unroll 1
  for (int item = blockIdx.x; item < 1536; item += gridDim.x) {
    bool isample;
    int seq, kvh, qb, rowbase, nchunk;
    if (item < 1024) { isample = true; qb = item & 15; kvh = (item >> 4) & 7; seq = item >> 7; rowbase = NPR + seq * 2048; nchunk = 5; }
    else { int i2 = item - 1024; isample = false; qb = i2 & 1; kvh = (i2 >> 1) & 7; seq = i2 >> 4; rowbase = seq * 256; nchunk = 2; }
    const int qrow = rowbase + qb * 128 + wid * 16;
    __syncthreads();
#pragma unroll
    for (int g = 0; g < 4; ++g)
#pragma unroll
      for (int it = 0; it < 2; ++it) {
        int piece = lane + it * 64;
        int r = piece >> 3, d0 = (piece & 7) * 8;
        h16x8 v = *reinterpret_cast<const h16x8*>(Q + (size_t)(qrow + r) * 2048 + kvh * 256 + g * 64 + d0);
        *reinterpret_cast<h16x8*>(Qs + (g * 128 + wid * 16 + r) * LDK + d0) = v;
      }
    const h16* qbase = Qs + (wid * 16 + fr) * LDK + fq * 8;
    const h16* kbase = Ks + fr * LDK + fq * 8;
    const h16* vbase = Vt + fr * LDV + fq * 4;
    float mx[4], sinkv[4];
#pragma unroll
    for (int g = 0; g < 4; ++g) { sinkv[g] = p.odd_sink[il * 32 + kvh * 4 + g] * 1.4426950408889634f; mx[g] = sinkv[g]; }
    const int qi = wid * 16 + fr;

    const h16* CK = (const h16*)(p.ws + OFF_CK);
    const h16* CV = (const h16*)(p.ws + OFF_CV);
    auto chunk = [&](int ch, bool& from_cache, int& krow, int& lo, int& hi) -> bool {
      from_cache = false; lo = -100000; hi = 100000; krow = 0;
      if (isample) {
        if (ch < 3) {
          int blk = qb - 1 + ch;
          if (blk < 0 || blk > 15) return false;
          krow = rowbase + blk * 128;
          if (ch == 0) lo = qi;
          if (ch == 2) hi = qi;
        } else { from_cache = true; krow = (ch - 3) * 128; }
      } else krow = rowbase + ch * 128;
      return true;
    };
    auto next_stage = [&](int st) -> int {
      for (++st; st < 2 * nchunk; ++st) {
        bool fc; int kr, lo, hi;
        if (chunk(st % nchunk, fc, kr, lo, hi)) return st;
      }
      return 2 * nchunk;
    };
    h16x8 pk[2], pv[2];
    auto fetch = [&](int st) {
      bool from_cache; int krow, lo, hi;
      chunk(st % nchunk, from_cache, krow, lo, hi);
      const bool withV = st >= nchunk;
#pragma unroll
      for (int it = 0; it < 2; ++it) {
        int piece = tid + it * 512;
        asm volatile("" : "+v"(piece));
        int key = piece >> 3, d0 = (piece & 7) * 8;
        const h16* ks; const h16* vs;
        if (from_cache) {
          size_t off = ((((size_t)seq * 2 + il) * 256 + krow + key) * 8 + kvh) * 64 + d0;
          ks = CK + off; vs = CV + off;
        } else {
          size_t off = (size_t)(krow + key) * 512 + kvh * 64 + d0;
          ks = KB + off; vs = VB + off;
        }
        pk[it] = *reinterpret_cast<const h16x8*>(ks);
        if (withV) {
          const int vkey = piece & 127, vd0 = (piece >> 7) * 8;
          const h16* vs2 = from_cache ? (CV + ((((size_t)seq * 2 + il) * 256 + krow + vkey) * 8 + kvh) * 64 + vd0)
                                      : (VB + (size_t)(krow + vkey) * 512 + kvh * 64 + vd0);
          pv[it] = *reinterpret_cast<const h16x8*>(vs2);
        }
      }
    };
    auto commit = [&](int st) {
      const bool withV = st >= nchunk;
#pragma unroll
      for (int it = 0; it < 2; ++it) {
        int piece = tid + it * 512;
        int key = piece >> 3, d0 = (piece & 7) * 8;
        *reinterpret_cast<h16x8*>(Ks + key * LDK + d0) = pk[it];
        if (withV) {
          const int vkey = piece & 127, vd0 = (piece >> 7) * 8;
#pragma unroll
          for (int q = 0; q < 8; ++q) Vt[(vd0 + q) * LDV + vkey] = pv[it][q];
        }
      }
    };

    int st = next_stage(nchunk - 1);
    fetch(st);
    f32x4 Lacc[4];
#pragma unroll
    for (int g = 0; g < 4; ++g) Lacc[g] = f32x4{0.f, 0.f, 0.f, 0.f};
    const h16x8 ones8 = {(h16)1.f, (h16)1.f, (h16)1.f, (h16)1.f, (h16)1.f, (h16)1.f, (h16)1.f, (h16)1.f};
    f32x4 O[4][4];
#pragma unroll
    for (int g = 0; g < 4; ++g)
#pragma unroll
      for (int n = 0; n < 4; ++n) O[g][n] = f32x4{0.f, 0.f, 0.f, 0.f};
#pragma unroll 1
    while (st < 2 * nchunk) {
      bool from_cache; int krow, lo, hi;
      chunk(st % nchunk, from_cache, krow, lo, hi);
      const bool masked = isample && ((st % nchunk) == 0 || (st % nchunk) == 2);
      __syncthreads();
      commit(st);
      __syncthreads();
      const int nst = next_stage(st);
      if (nst < 2 * nchunk) fetch(nst);
      {
        const int cidx2 = st % nchunk;
        const int k2lo = (masked && cidx2 == 0) ? (wid >> 1) : 0;
        const int k2hi = (masked && cidx2 == 2) ? (wid >> 1) : 3;
#pragma unroll 1
        for (int k2 = k2lo; k2 <= k2hi; ++k2) {
          h16x8 vf[4];
#pragma unroll
          for (int n = 0; n < 4; ++n) {
            h16x4 lo4 = *reinterpret_cast<const h16x4*>(vbase + n * 16 * LDV + k2 * 32);
            h16x4 hi4 = *reinterpret_cast<const h16x4*>(vbase + n * 16 * LDV + k2 * 32 + 16);
            vf[n] = h16x8{lo4[0], lo4[1], lo4[2], lo4[3], hi4[0], hi4[1], hi4[2], hi4[3]};
          }
          h16x8 ka[2][2];
#pragma unroll
          for (int tt = 0; tt < 2; ++tt)
#pragma unroll
            for (int ks = 0; ks < 2; ++ks)
              ka[tt][ks] = *reinterpret_cast<const h16x8*>(kbase + (k2 * 32 + tt * 16) * LDK + ks * 32);
#pragma unroll
          for (int g = 0; g < 4; ++g) {
            const h16x8 q0 = *reinterpret_cast<const h16x8*>(qbase + g * 128 * LDK);
            const h16x8 q1 = *reinterpret_cast<const h16x8*>(qbase + g * 128 * LDK + 32);
            float sv[8];
#pragma unroll
            for (int tt = 0; tt < 2; ++tt) {
              f32x4 sc = {0.f, 0.f, 0.f, 0.f};
              sc = __builtin_amdgcn_mfma_f32_16x16x32_f16(ka[tt][0], q0, sc, 0, 0, 0);
              sc = __builtin_amdgcn_mfma_f32_16x16x32_f16(ka[tt][1], q1, sc, 0, 0, 0);
              if (masked) {
                asm volatile("");
#pragma unroll
                for (int j = 0; j < 4; ++j) {
                  const int kj = k2 * 32 + tt * 16 + fq * 4 + j;
                  sv[tt * 4 + j] = (kj >= lo && kj <= hi) ? sc[j] : -1e30f;
                }
              } else {
#pragma unroll
                for (int j = 0; j < 4; ++j) sv[tt * 4 + j] = sc[j];
              }
            }
            float smax = fmaxf(fmaxf(fmaxf(sv[0], sv[1]), fmaxf(sv[2], sv[3])), fmaxf(fmaxf(sv[4], sv[5]), fmaxf(sv[6], sv[7])));
            if (__any(smax > mx[g] + 8.f)) {
              smax = fmaxf(smax, __shfl_xor(smax, 16));
              smax = fmaxf(smax, __shfl_xor(smax, 32));
              const float mnew = fmaxf(mx[g], smax);
              const float alpha = __builtin_amdgcn_exp2f(mx[g] - mnew);
              mx[g] = mnew;
#pragma unroll
              for (int j = 0; j < 4; ++j) {
                const float al = __shfl(alpha, fq * 4 + j);
                Lacc[g][j] *= al;
#pragma unroll
                for (int n = 0; n < 4; ++n) O[g][n][j] *= al;
              }
            }
            float pe[8];
#pragma unroll
            for (int i = 0; i < 8; ++i) pe[i] = __builtin_amdgcn_exp2f(sv[i] - mx[g]);
            union { unsigned u[4]; h16x8 h; } pfu;
#pragma unroll
            for (int q = 0; q < 4; ++q) {
              auto pk2 = __builtin_amdgcn_cvt_pkrtz(pe[2 * q], pe[2 * q + 1]);
              pfu.u[q] = __builtin_bit_cast(unsigned, pk2);
            }
            const h16x8 pf = pfu.h;
            Lacc[g] = __builtin_amdgcn_mfma_f32_16x16x32_f16(pf, ones8, Lacc[g], 0, 0, 0);
#pragma unroll
            for (int n = 0; n < 4; ++n) O[g][n] = __builtin_amdgcn_mfma_f32_16x16x32_f16(pf, vf[n], O[g][n], 0, 0, 0);
          }
        }
      }
      st = nst;
    }
#pragma unroll
    for (int g = 0; g < 4; ++g) {
      const float sterm = __builtin_amdgcn_exp2f(sinkv[g] - mx[g]);
#pragma unroll
      for (int j = 0; j < 4; ++j) {
        const float li = __builtin_amdgcn_rcpf(Lacc[g][j] + __shfl(sterm, fq * 4 + j));
        h16* srow = Qs + (g * 128 + wid * 16 + fq * 4 + j) * LDK + fr;
#pragma unroll
        for (int n = 0; n < 4; ++n) srow[n * 16] = (h16)(O[g][n][j] * li);
      }
    }
    {
      const int q2 = lane >> 2, g2 = lane & 3;
      const int row = qrow + q2;
      const h16* src = Qs + (g2 * 128 + wid * 16 + q2) * LDK;
      const size_t goff = (size_t)row * 2048 + (kvh * 4 + g2) * 64;
#pragma unroll
      for (int e = 0; e < 8; ++e) {
        const h16x8 ov = *reinterpret_cast<const h16x8*>(src + e * 8);
        const h16x8 gv = *reinterpret_cast<const h16x8*>(GT + goff + e * 8);
        h16x8 yv;
#pragma unroll
        for (int q = 0; q < 8; ++q) yv[q] = (h16)((float)ov[q] * siluf_((float)gv[q]));
        *reinterpret_cast<h16x8*>(Y + goff + e * 8) = yv;
      }
    }
  }
  __builtin_amdgcn_s_setprio(0);
  __syncthreads();
}

__device__ __forceinline__ void gemm_even_in(const Params& p, const int swid, int il) {
  const h16* H = (const h16*)(p.ws + OFF_H);
  const h16* WT = (const h16*)(p.ws + OFF_WT);
  Epi e{};
  e.o0 = (h16*)(p.ws + OFF_PA);
  e.o1 = (h16*)(p.ws + OFF_PB);
  e.o2 = (h16*)(p.ws + OFF_PB) + NT1K;
  e.o3 = (h16*)(p.ws + OFF_PB) + NT1K + (size_t)NT * 2048;
  e.il = il;
  for (int step = 0;; ++step) {
    int pm, pn;
    if (!tile_of(step, 96, 29, pm, pn)) break;
    gemm_tile<M_EVEN_IN>(swid, H, H, 1 << 30, 2048, WT, 2048, 2048, pm * 256, pn * 256, e);
  }
}
__device__ __forceinline__ void gemm_odd_in(const Params& p, const int swid, int il) {
  const h16* H = (const h16*)(p.ws + OFF_H);
  const h16* WT = (const h16*)(p.ws + OFF_WT);
  Epi e{};
  e.o0 = (h16*)(p.ws + OFF_PA);
  e.o1 = (h16*)(p.ws + OFF_PB);
  e.o2 = (h16*)(p.ws + OFF_PB) + (size_t)NT * 512;
  e.o3 = (h16*)(p.ws + OFF_PB) + NT1K;
  e.f0 = p.out + OUT_K;
  e.f1 = p.out + OUT_V;
  e.rope = (const float*)(p.ws + OFF_ROPE);
  e.il = il;
  for (int step = 0;; ++step) {
    int pm, pn;
    if (!tile_of(step, 96, 20, pm, pn)) break;
    gemm_tile<M_ODD_IN>(swid, H, H, 1 << 30, 2048, WT, 2048, 2048, pm * 256, pn * 256, e);
  }
}
__device__ __forceinline__ void gemm_out(const Params& p, const int swid, bool even) {
  const h16* WO = (const h16*)(p.ws + OFF_WO);
  Epi e{};
  e.o0 = (h16*)(p.ws + OFF_C);
  const h16* A0;
  const h16* A1;
  int ksplit, lda;
  if (even) { A0 = (const h16*)(p.ws + OFF_PB); A1 = A0 + NT1K + (size_t)NT * 2048; ksplit = 16; lda = 1024; }
  else { A0 = (const h16*)(p.ws + OFF_H); A1 = A0; ksplit = 1 << 30; lda = 2048; }
  for (int step = 0;; ++step) {
    int pm, pn;
    if (!tile_of(step, 96, 8, pm, pn)) break;
    gemm_tile<M_OUT_F32>(swid, A0, A1, ksplit, lda, WO, 2048, 2048, pm * 256, pn * 256, e);
  }
}

constexpr int NPHASE = 22;
__device__ __forceinline__ void phase_decode(int ph, int& kind, int& layer) {
  if (ph < 2) { kind = ph; layer = 0; return; }
  int q = ph - 2;
  if (q < 6) { layer = 0; kind = 2 + q; if (q >= 4) kind = 6 + (q - 4); return; }
  q -= 6;
  if (q < 4) { layer = 1; kind = (q == 0) ? 8 : (q == 1) ? 9 : (q == 2) ? 6 : 7; return; }
  q -= 4;
  if (q < 6) { layer = 2; kind = 2 + q; if (q >= 4) kind = 6 + (q - 4); return; }
  q -= 6;
  layer = 3;
  kind = (q == 0) ? 8 : (q == 1) ? 9 : (q == 2) ? 6 : 7;
}

__global__ void __launch_bounds__(NTHR, 2) mega(Params p, int ph_lo, int ph_hi) {
  cg::grid_group grid = cg::this_grid();
  const int swid = __builtin_amdgcn_readfirstlane((int)(__builtin_amdgcn_workitem_id_x() >> 6));
  const bool leader_thread = (__builtin_amdgcn_workitem_id_x() == 0);
  volatile LAS unsigned* xst = (volatile LAS unsigned*)(smem + 140288);
  if (leader_thread) { xst[0] = 0u; xst[1] = 0u; }
  __syncthreads();
  XcdBarrier xb;
  xb.bar = (unsigned*)(p.ws + OFF_BAR); xb.x = xb_xcc_id(); xb.st = xst;
  if (leader_thread) (void)xb_add(&xb.bar[XB_XCNT(xb.x)], 1u);
  for (int ph = ph_lo; ph < ph_hi; ++ph) {
    int kind, layer;
    phase_decode(ph, kind, layer);
    const int il = layer >> 1;
#ifdef PROBE_KIND
    if (kind == PROBE_KIND) {
      switch (kind) {
        case 2: gemm_even_in(p, swid, il); break;
        case 3: even_prep(p, swid, il); break;
        case 4: even_scan(p, swid, il); break;
        case 6: gemm_out(p, swid, (layer & 1) == 0); break;
        case 8: gemm_odd_in(p, swid, il); break;
        case 9: attention(p, swid, il); break;
      }
      grid.sync();
    }
#endif
    switch (kind) {
      case 0: phase0(p, swid); break;
      case 1:
        for (int t = blockIdx.x; t < 64; t += gridDim.x) fold_tile(p, swid, 0, t);
        norm_rows(p, swid, -1, 0);
        break;
      case 2: gemm_even_in(p, swid, il); break;
      case 3: dft2_tiles(p, swid); even_prep(p, swid, il); break;
      case 4: even_scan(p, swid, il); break;
      case 5: even_post(p, swid, il); break;
      case 6: gemm_out(p, swid, (layer & 1) == 0); break;
      case 7: {
        if (layer < 3) {
          const int nl = layer + 1;
          if ((nl & 1) == 0)
            for (int t = blockIdx.x; t < 64; t += gridDim.x) fold_tile(p, swid, nl >> 1, t);
          const int nc = conv_items(nl);
          conv_run(p, swid, nl, blockIdx.x, gridDim.x, nc);
        }
        norm_rows(p, swid, layer, layer + 1);
      } break;
      case 8: gemm_odd_in(p, swid, il); break;
      case 9: attention(p, swid, il); break;
    }
    if (ph + 1 < ph_hi) { if (ph == 0) grid.sync(); else xcd_barrier(xb, leader_thread); }
  }
}

extern "C" void kernel_launch(void* const* d_in, const int* in_sizes, int n_in, void* d_out, int out_size, void* d_ws,
                              size_t ws_size, hipStream_t stream) {
  Params p{};
  const float** pp = (const float**)&p;
  for (int i = 0; i < 26; ++i) pp[i] = (const float*)d_in[i];
  p.out = (float*)d_out;
  p.ws = (char*)d_ws;
  static int grid_blocks = 0;
  if (!grid_blocks) {
    hipFuncSetAttribute((const void*)mega, hipFuncAttributeMaxDynamicSharedMemorySize, (int)SMEM_BYTES);
    int dev = 0, cus = 0, per_cu = 0;
    hipGetDevice(&dev);
    hipDeviceGetAttribute(&cus, hipDeviceAttributeMultiprocessorCount, dev);
    hipOccupancyMaxActiveBlocksPerMultiprocessor(&per_cu, mega, NTHR, SMEM_BYTES);
    if (per_cu < 1) per_cu = 1;
    if (per_cu > 1) per_cu = 1;
    grid_blocks = 256;
    if (ws_size < WS_TOTAL) fprintf(stderr, "workspace too small: %zu < %zu\n", ws_size, WS_TOTAL);
  }
#if COOP
  (void)hipMemsetAsync((char*)d_ws + OFF_BAR, 0, XCD_BAR_WORDS_C * 4, stream);
  int lo = 0, hi = NPHASE;
  void* args[] = {&p, &lo, &hi};
  hipError_t e = hipLaunchCooperativeKernel((void*)mega, dim3(grid_blocks), dim3(NTHR), args, SMEM_BYTES, stream);
  if (e != hipSuccess) fprintf(stderr, "cooperative launch failed: %s (grid %d)\n", hipGetErrorString(e), grid_blocks);
#else
  for (int ph = 0; ph < NPHASE; ++ph) mega<<<grid_blocks, NTHR, SMEM_BYTES, stream>>>(p, ph, ph + 1);
#endif
}
```

```cpp
#include <hip/hip_runtime.h>
#include <hip/hip_fp16.h>
#include <hip/hip_cooperative_groups.h>
#include <cstdio>
namespace cg = cooperative_groups;

typedef _Float16 h16;
typedef __attribute__((ext_vector_type(8))) _Float16 h16x8;
typedef __attribute__((ext_vector_type(4))) _Float16 h16x4;
typedef __attribute__((ext_vector_type(4))) float f32x4;
typedef __attribute__((ext_vector_type(2))) float f32x2;

#ifndef COOP
#define COOP 1
#endif

constexpr int NT = 24576;
constexpr int NPR = 8192;
constexpr int DM = 2048;
constexpr int NTHR = 512;
constexpr size_t SMEM_BYTES = 148480 + 16;
constexpr size_t XCD_BAR_WORDS_C = 3456;

constexpr size_t SZ_WT = (size_t)7424 * 2048 * 2;
constexpr size_t OFF_WT = 0;
constexpr size_t OFF_WO = OFF_WT + SZ_WT;
constexpr size_t OFF_WU = OFF_WO + (size_t)2048 * 2048 * 2;
constexpr size_t OFF_TWC = OFF_WU + (size_t)2 * 2048 * 1024 * 2;
constexpr size_t OFF_TW2048 = OFF_TWC + (size_t)2 * 256 * 256 * 2;
constexpr size_t OFF_TW256 = OFF_TW2048 + (size_t)2048 * 4096 * 2;
constexpr size_t OFF_MOD = OFF_TW256 + (size_t)256 * 512 * 2;
constexpr size_t OFF_ROPE = OFF_MOD + (size_t)4 * 9 * 6144 * 4;
constexpr size_t OFF_LW = OFF_ROPE + (size_t)64 * 16 * 2 * 4;
constexpr size_t OFF_RN = OFF_LW + (size_t)8 * 1024 * 64 * 2;
constexpr size_t OFF_H = OFF_RN + (size_t)NT * 16 * 4;
constexpr size_t OFF_PA = OFF_H + (size_t)NT * 2048 * 2;
constexpr size_t OFF_PB = OFF_PA + (size_t)NT * 3328 * 2;
constexpr size_t OFF_C = OFF_PB + (size_t)NT * 4096 * 2;
constexpr size_t WS_NEED = OFF_C + (size_t)NT * 1024 * 2 * 5;
constexpr size_t OFF_BAR = WS_NEED;
constexpr size_t OFF_CK = OFF_BAR + 16384;
constexpr size_t CACHE_ELEMS = (size_t)8 * 2 * 256 * 512;
constexpr size_t OFF_CV = OFF_CK + CACHE_ELEMS * 2;
constexpr size_t OFF_PART = OFF_CV + CACHE_ELEMS * 2;
constexpr size_t WS_TOTAL = OFF_PART + (size_t)4 * 8 * 9 * 6144 * 4;
constexpr size_t NT1K = (size_t)NT * 1024;

constexpr size_t OUT_STATE = (size_t)NT * 2048;
constexpr size_t OUT_K = OUT_STATE + (size_t)32 * 2 * 2 * 16 * 64 * 64;
constexpr size_t OUT_V = OUT_K + (size_t)32 * 2 * 256 * 512;

struct Params {
  const float *x_prompt, *x_sample, *c, *state_wkv, *cache_k, *cache_v, *c_ctx, *mod_w, *mod_b, *norm_pre, *norm_post;
  const float *even_w_in, *even_mu, *even_w0, *even_w_up, *even_a0, *even_a_up, *even_k_k, *even_k_a, *even_r_k, *even_gn_w,
      *even_gn_b, *even_w_out;
  const float *odd_w_in, *odd_sink, *odd_w_out;
  float* out;
  char* ws;
};

extern __shared__ __attribute__((aligned(16))) char smem[];
__device__ __forceinline__ int lane_id_() {
  int l;
  asm volatile("v_mbcnt_lo_u32_b32 %0, -1, 0\n\tv_mbcnt_hi_u32_b32 %0, -1, %0" : "=v"(l));
  return l;
}
#define TIDX (swid * 64 + lane_id_())


__device__ __forceinline__ float wave_sum(float v) {
#pragma unroll
  for (int o = 32; o >= 1; o >>= 1) v += __shfl_xor(v, o);
  return v;
}
__device__ __forceinline__ float sigmoidf_(float x) { return __builtin_amdgcn_rcpf(1.f + __expf(-x)); }
__device__ __forceinline__ float siluf_(float x) { return x * __builtin_amdgcn_rcpf(1.f + __expf(-x)); }


#define XB_TMO      128
#define XB_XCNT(j)  (256  + 64 * (j))
#define XB_XSUB(j)  (1280 + 64 * (j))
#define XB_XGEN(j)  (2304 + 64 * (j))
#define XB_TOP      3328
#define XB_TOPGEN   3392
#define XCD_BAR_WORDS 3456
#define XB_SPIN_CAP (1u << 18)
#define LAS __attribute__((address_space(3)))
__device__ __forceinline__ unsigned xb_ld(unsigned* p) { return __hip_atomic_load(p, __ATOMIC_RELAXED, __HIP_MEMORY_SCOPE_AGENT); }
__device__ __forceinline__ unsigned xb_add(unsigned* p, unsigned v) { return __hip_atomic_fetch_add(p, v, __ATOMIC_RELAXED, __HIP_MEMORY_SCOPE_AGENT); }
__device__ __forceinline__ unsigned xb_xcc_id() { return (unsigned)__builtin_amdgcn_s_getreg((3 << 11) | 20) & 0xFu; }
#define XB_SPIN(cond, bar) do { unsigned _sp = 0; while (cond) { __builtin_amdgcn_s_sleep(1); \
    if ((++_sp & 255u) == 0u) { if (xb_ld(&(bar)[XB_TMO])) break; if (_sp > XB_SPIN_CAP) { atomicAdd(&(bar)[XB_TMO], 1u); break; } } } } while (0)
struct XcdBarrier { unsigned* bar; unsigned x; volatile LAS unsigned* st; };
__device__ __forceinline__ void xcd_barrier_complete(unsigned* bar, unsigned x, unsigned& nloc, unsigned& nx) {
  const unsigned G = gridDim.x;
  unsigned sum, cnt, mine, sp = 0u;
  for (;;) {
    sum = 0u; cnt = 0u; mine = 0u;
#pragma unroll
    for (unsigned j = 0; j < 16; ++j) { const unsigned c = xb_ld(&bar[XB_XCNT(j)]); sum += c; cnt += (c > 0u) ? 1u : 0u; mine = (j == x) ? c : mine; }
    if (sum == G) break;
    __builtin_amdgcn_s_sleep(1);
    if ((++sp & 255u) == 0u) { if (xb_ld(&bar[XB_TMO])) break; if (sp > XB_SPIN_CAP) { atomicAdd(&bar[XB_TMO], 1u); break; } }
  }
  nloc = mine > 0u ? mine : 1u; nx = cnt > 0u ? cnt : 1u;
}
__device__ __forceinline__ void xcd_barrier(const XcdBarrier& b, const bool leader_thread) {
  asm volatile("s_waitcnt vmcnt(0)" ::: "memory");
  __syncthreads();
  if (leader_thread) {
    unsigned* bar = b.bar;
    __builtin_amdgcn_s_waitcnt(0);
    unsigned nloc = b.st[0], nx = b.st[1];
    if (nloc == 0u) { xcd_barrier_complete(bar, b.x, nloc, nx); b.st[0] = nloc; b.st[1] = nx; }
    const unsigned old = xb_add(&bar[XB_XSUB(b.x)], 1u);
    const unsigned gen = old / nloc;
    if (old + 1u == (gen + 1u) * nloc) {
      __builtin_amdgcn_fence(__ATOMIC_RELEASE, "agent");
      asm volatile("s_waitcnt vmcnt(0)" ::: "memory");
      const unsigned og = xb_add(&bar[XB_TOP], 1u);
      const unsigned tg = og / nx;
      if (og + 1u == (tg + 1u) * nx) xb_add(&bar[XB_TOPGEN], 1u);
      else XB_SPIN(xb_ld(&bar[XB_TOPGEN]) == tg, bar);
      __builtin_amdgcn_fence(__ATOMIC_ACQUIRE, "agent");
      xb_add(&bar[XB_XGEN(b.x)], 1u);
      asm volatile("s_waitcnt vmcnt(0)" ::: "memory");
    } else {
      XB_SPIN(xb_ld(&bar[XB_XGEN(b.x)]) == gen, bar);
      __builtin_amdgcn_fence(__ATOMIC_ACQUIRE, "agent");
      asm volatile("s_waitcnt vmcnt(0)" ::: "memory");
    }
  }
  __syncthreads();
}

constexpr int BK = 64, HALF = 128, HT = HALF * BK;

__device__ __forceinline__ int lds_byte(int r, int c) {
  int st = (r >> 4) * 2 + (c >> 5), rr = r & 15, cc = c & 31, ob = rr * 64 + cc * 2;
  return st * 1024 + (ob ^ (((ob >> 9) & 1) << 5));
}
__device__ __forceinline__ void stage_rc(int b, int& R, int& C) {
  int st = b / 1024, sb = b % 1024, swz = sb ^ (((sb >> 9) & 1) << 5);
  R = (st >> 1) * 16 + swz / 64;
  C = (st & 1) * 32 + (swz % 64) / 2;
}

constexpr float QSC = 0.18033688011112042f;
enum { M_EVEN_IN = 0, M_OUT_F32 = 1, M_ODD_IN = 2, M_FOLD = 3, M_DFT2 = 4 };

struct Epi {
  h16* o0;
  h16* o1;
  h16* o2;
  h16* o3;
  float* f0;
  float* f1;
  const float* rope;
  int il;
  int aux;
  float scale;
};

__device__ __forceinline__ float4 cs_ld4(const float* cs, int r, int c) {
  return *reinterpret_cast<const float4*>(cs + r * 256 + (c ^ (((r >> 2) & 3) << 4)));
}
__device__ __forceinline__ float cs_ld1(const float* cs, int r, int c) { return cs[r * 256 + (c ^ (((r >> 2) & 3) << 4))]; }
__device__ __forceinline__ h16x4 cvt4(float4 v) {
  h16x4 o;
  o[0] = (h16)v.x; o[1] = (h16)v.y; o[2] = (h16)v.z; o[3] = (h16)v.w;
  return o;
}

template <int MODE>
__device__ __forceinline__ void epi_store(const int swid, const float* cs, int grow0, int bcol, const Epi& e) {
  const int tid = TIDX, wid = tid >> 6, lane = tid & 63;
  if (MODE == M_EVEN_IN && bcol >= 4352 && bcol < 6400) {
    size_t sbase;
    int T, t0;
    if (grow0 < NPR) { sbase = (size_t)(grow0 >> 8) * 524288; T = 256; t0 = grow0 & 255; }
    else { int r2 = grow0 - NPR; sbase = (size_t)16777216 + (size_t)(r2 >> 11) * 4194304; T = 2048; t0 = r2 & 2047; }
#pragma unroll 1
    for (int it = 0; it < 2; ++it) {
      const int idx = it * 512 + tid;
      const int col = idx & 255, rg = idx >> 8;
      const int np = bcol + col - 4352;
      const int csn = np >> 10, gf = np & 1023;
      h16* dst = e.o2 + sbase + ((size_t)gf * 2 + csn) * T + t0 + rg * 32;
#pragma unroll
      for (int part = 0; part < 4; ++part) {
        h16x8 o;
#pragma unroll
        for (int q = 0; q < 8; ++q) o[q] = (h16)cs_ld1(cs, rg * 32 + part * 8 + q, col);
        *reinterpret_cast<h16x8*>(dst + part * 8) = o;
      }
    }
    return;
  }
  if (MODE == M_ODD_IN && bcol < 2560) {
    const bool sample = grow0 >= NPR;
    const bool isq = bcol < 2048;
#pragma unroll 1
    for (int it = 0; it < 8; ++it) {
      const int r = it * 16 + wid * 2 + (lane >> 5);
      const int l5 = lane & 31, grp = l5 >> 2, sub = l5 & 3;
      const int c = grp * 32 + sub * 4;
      const int row = grow0 + r;
      float4 v1 = cs_ld4(cs, r, c), v2 = cs_ld4(cs, r, c + 16);
      float4 r1 = v1, r2 = v2;
      if (sample) {
        const int t = (row - NPR) & 2047;
        const int pos = (grp & 1) ? (t & 63) : (t >> 6);
        const float4 ra = *reinterpret_cast<const float4*>(e.rope + (pos * 16 + sub * 4) * 2);
        const float4 rb = *reinterpret_cast<const float4*>(e.rope + (pos * 16 + sub * 4) * 2 + 4);
        r1.x = v1.x * ra.x - v2.x * ra.y; r2.x = v2.x * ra.x + v1.x * ra.y;
        r1.y = v1.y * ra.z - v2.y * ra.w; r2.y = v2.y * ra.z + v1.y * ra.w;
        r1.z = v1.z * rb.x - v2.z * rb.y; r2.z = v2.z * rb.x + v1.z * rb.y;
        r1.w = v1.w * rb.z - v2.w * rb.w; r2.w = v2.w * rb.z + v1.w * rb.w;
      }
      if (isq) {
        r1.x *= QSC; r1.y *= QSC; r1.z *= QSC; r1.w *= QSC;
        r2.x *= QSC; r2.y *= QSC; r2.z *= QSC; r2.w *= QSC;
        h16* dst = e.o0 + (size_t)row * 2048 + bcol + c;
        *reinterpret_cast<h16x4*>(dst) = cvt4(r1);
        *reinterpret_cast<h16x4*>(dst + 16) = cvt4(r2);
      } else {
        const int cp = bcol - 2048 + c;
        h16* dst = e.o1 + (size_t)row * 512 + cp;
        *reinterpret_cast<h16x4*>(dst) = cvt4(r1);
        *reinterpret_cast<h16x4*>(dst + 16) = cvt4(r2);
        if (!sample) {
          float* fo = e.f0 + ((size_t)((row >> 8) * 2 + e.il) * 256 + (row & 255)) * 512 + cp;
          *reinterpret_cast<float4*>(fo) = v1;
          *reinterpret_cast<float4*>(fo + 16) = v2;
        }
      }
    }
    return;
  }
#pragma unroll 1
  for (int it = 0; it < 8; ++it) {
    const int r = it * 16 + wid * 2 + (lane >> 5);
    const int c = (lane & 31) * 8;
    const int row = grow0 + r, col = bcol + c;
    const float4 va = cs_ld4(cs, r, c), vb = cs_ld4(cs, r, c + 4);
    h16x8 hv;
    hv[0] = (h16)va.x; hv[1] = (h16)va.y; hv[2] = (h16)va.z; hv[3] = (h16)va.w;
    hv[4] = (h16)vb.x; hv[5] = (h16)vb.y; hv[6] = (h16)vb.z; hv[7] = (h16)vb.w;
    if (MODE == M_OUT_F32 || MODE == M_FOLD) {
      *reinterpret_cast<h16x8*>(e.o0 + (size_t)row * 2048 + col) = hv;
    } else if (MODE == M_DFT2) {
      h16* ptr = e.o0 + (size_t)row * 1024 + e.aux + col;
      const h16x8 g = *reinterpret_cast<const h16x8*>(ptr);
      const float vv[8] = {va.x, va.y, va.z, va.w, vb.x, vb.y, vb.z, vb.w};
      h16x8 o;
#pragma unroll
      for (int q = 0; q < 8; ++q) o[q] = (h16)(vv[q] * e.scale * siluf_((float)g[q]));
      *reinterpret_cast<h16x8*>(ptr) = o;
    } else if (MODE == M_EVEN_IN) {
      if (bcol < 3328) *reinterpret_cast<h16x8*>(e.o0 + (size_t)row * 3328 + col) = hv;
      else if (bcol < 4352) *reinterpret_cast<h16x8*>(e.o1 + (size_t)row * 1024 + (col - 3328)) = hv;
      else *reinterpret_cast<h16x8*>(e.o3 + (size_t)row * 1024 + (col - 6400)) = hv;
    } else if (MODE == M_ODD_IN) {
      const bool sample = grow0 >= NPR;
      if (bcol < 3072) {
        const int cp = col - 2560;
        *reinterpret_cast<h16x8*>(e.o2 + (size_t)row * 512 + cp) = hv;
        if (!sample) {
          float* fo = e.f1 + ((size_t)((row >> 8) * 2 + e.il) * 256 + (row & 255)) * 512 + cp;
          *reinterpret_cast<float4*>(fo) = va;
          *reinterpret_cast<float4*>(fo + 4) = vb;
        }
      } else {
        *reinterpret_cast<h16x8*>(e.o3 + (size_t)row * 2048 + (col - 3072)) = hv;
      }
    }
  }
}

template <int MODE>
__device__ __forceinline__ void gemm_tile(const int swid, const h16* __restrict__ A0, const h16* __restrict__ A1, int ksplit, int lda,
                                          const h16* __restrict__ Bt, int ldb, int K, int brow, int bcol, const Epi& e) {
  h16* shm = (h16*)smem;
  asm volatile("" : "+s"(K), "+s"(lda), "+s"(ldb));
#define SA(b, h) (shm + ((b) * 2 + (h)) * HT)
#define SB(b, h) (shm + (4 + (b) * 2 + (h)) * HT)
#define STAGE_A(P, br, kt)                                                                                      \
  do {                                                                                                          \
    unsigned long long _ub = (unsigned long long)((((kt) < ksplit) ? (A0 + (long)(kt) * BK) : (A1 + (long)((kt) - ksplit) * BK)) + (long)(br) * lda); \
    asm volatile("" : "+s"(_ub)); \
    __builtin_amdgcn_global_load_lds((const unsigned*)((const char*)_ub + offA0), (unsigned*)((char*)(P) + swid * 1024), 16, 0, 0); \
    __builtin_amdgcn_global_load_lds((const unsigned*)((const char*)_ub + offA1), (unsigned*)((char*)(P) + swid * 1024 + 8192), 16, 0, 0); \
  } while (0)
#define STAGE_B(P, bc, kt)                                                                                      \
  do {                                                                                                          \
    unsigned long long _ub = (unsigned long long)(Bt + (long)(kt) * BK + (long)(bc) * ldb); \
    asm volatile("" : "+s"(_ub)); \
    __builtin_amdgcn_global_load_lds((const unsigned*)((const char*)_ub + offB0), (unsigned*)((char*)(P) + swid * 1024), 16, 0, 0); \
    __builtin_amdgcn_global_load_lds((const unsigned*)((const char*)_ub + offB1), (unsigned*)((char*)(P) + swid * 1024 + 8192), 16, 0, 0); \
  } while (0)
#define LDA(dst, b, h)                                                                                          \
  for (int m = 0; m < 4; ++m)                                                                                   \
    for (int k = 0; k < 2; ++k)                                                                                 \
  dst[m][k] = *reinterpret_cast<const h16x8*>(pa_lds + (((b) * 2 + (h)) * HT * 2 + m * 2048 + k * 1024))
#define LDB(dst, b, h)                                                                                          \
  for (int n = 0; n < 2; ++n)                                                                                   \
    for (int k = 0; k < 2; ++k)                                                                                 \
  dst[n][k] = *reinterpret_cast<const h16x8*>(pb_lds + (((4 + (b) * 2 + (h)) * HT * 2) + n * 2048 + k * 1024))
#define MMA(ai, bj, At, Bq)                                                                                     \
  do {                                                                                                          \
    __builtin_amdgcn_s_setprio(1);                                                                              \
    for (int m = 0; m < 4; ++m)                                                                                 \
      for (int n = 0; n < 2; ++n)                                                                               \
        for (int k = 0; k < 2; ++k)                                                                             \
          acc[ai][bj][m][n] = __builtin_amdgcn_mfma_f32_16x16x32_f16(At[m][k], Bq[n][k], acc[ai][bj][m][n], 0, 0, 0); \
    __builtin_amdgcn_s_setprio(0);                                                                              \
  } while (0)
#define WAIT_V(n) asm volatile("s_waitcnt vmcnt(" #n ")" ::: "memory")
#define WAIT_L(n) asm volatile("s_waitcnt lgkmcnt(" #n ")" ::: "memory")
#define BAR __builtin_amdgcn_s_barrier()
#define SCHED __builtin_amdgcn_sched_barrier(0)

  const int wid = swid, lane = lane_id_(), wr = wid >> 2, wc = wid & 3, fr = lane & 15, fq = lane >> 4;
  unsigned offA0, offA1, offB0, offB1;
  {
    int r0, c0, r1, c1;
    const int tb = (swid * 64 + lane) * 16;
    stage_rc(tb, r0, c0);
    stage_rc(tb + 8192, r1, c1);
    offA0 = (unsigned)(r0 * lda + c0) * 2u; offA1 = (unsigned)(r1 * lda + c1) * 2u;
    offB0 = (unsigned)(r0 * ldb + c0) * 2u; offB1 = (unsigned)(r1 * ldb + c1) * 2u;
  }
  const char* pa_lds = (const char*)smem + lds_byte(wr * 64 + fr, fq * 8);
  const char* pb_lds = (const char*)smem + lds_byte(wc * 32 + fr, fq * 8);
  f32x4 acc[2][2][4][2] = {};
  h16x8 At[4][2], B0[2][2], B1[2][2];
  const int nt = K / BK;
  STAGE_B(SB(0, 0), bcol, 0);
  STAGE_A(SA(0, 0), brow, 0);
  STAGE_B(SB(0, 1), bcol + HALF, 0);
  STAGE_A(SA(0, 1), brow + HALF, 0);
  if (wr == 1) BAR;
  WAIT_V(4);
  BAR;
  STAGE_B(SB(1, 0), bcol, 1);
  STAGE_A(SA(1, 0), brow, 1);
  STAGE_B(SB(1, 1), bcol + HALF, 1);
  WAIT_V(6);
  BAR;
  for (int t = 0; t < nt - 2; t += 2) {
    LDB(B0, 0, 0); SCHED; LDA(At, 0, 0); STAGE_A(SA(1, 1), brow + HALF, t + 1);
    WAIT_L(8); BAR; WAIT_L(0); MMA(0, 0, At, B0); BAR; SCHED;
    LDB(B1, 0, 1); STAGE_B(SB(0, 0), bcol, t + 2);
    BAR; WAIT_L(0); MMA(0, 1, At, B1); BAR;
    LDA(At, 0, 1); STAGE_A(SA(0, 0), brow, t + 2);
    BAR; WAIT_L(0); MMA(1, 0, At, B0); BAR; SCHED;
    STAGE_B(SB(0, 1), bcol + HALF, t + 2);
    WAIT_V(6); BAR; MMA(1, 1, At, B1); BAR;
    LDB(B0, 1, 0); SCHED; LDA(At, 1, 0); STAGE_A(SA(0, 1), brow + HALF, t + 2);
    WAIT_L(8); BAR; WAIT_L(0); MMA(0, 0, At, B0); BAR; SCHED;
    LDB(B1, 1, 1); STAGE_B(SB(1, 0), bcol, t + 3);
    BAR; WAIT_L(0); MMA(0, 1, At, B1); BAR;
    LDA(At, 1, 1); STAGE_A(SA(1, 0), brow, t + 3);
    BAR; WAIT_L(0); MMA(1, 0, At, B0); BAR; SCHED;
    STAGE_B(SB(1, 1), bcol + HALF, t + 3);
    WAIT_V(6); BAR; MMA(1, 1, At, B1); BAR;
  }
  {
    LDB(B0, 0, 0); LDA(At, 0, 0); STAGE_A(SA(1, 1), brow + HALF, nt - 1);
    BAR; WAIT_L(0); MMA(0, 0, At, B0); BAR;
    LDB(B1, 0, 1); BAR; WAIT_L(0); MMA(0, 1, At, B1); BAR;
    LDA(At, 0, 1); WAIT_V(4); BAR; WAIT_L(0); MMA(1, 0, At, B0); MMA(1, 1, At, B1); BAR;
  }
  {
    LDB(B0, 1, 0); LDA(At, 1, 0); WAIT_V(2); BAR; WAIT_L(0); MMA(0, 0, At, B0); BAR;
    LDB(B1, 1, 1); WAIT_V(0); BAR; WAIT_L(0); MMA(0, 1, At, B1); BAR;
    LDA(At, 1, 1); BAR; WAIT_L(0); MMA(1, 0, At, B0); MMA(1, 1, At, B1); BAR;
  }
  if (wr == 0) BAR;

  {
    float* cs = (float*)smem;
#pragma unroll
    for (int ai = 0; ai < 2; ++ai) {
#pragma unroll
      for (int bj = 0; bj < 2; ++bj)
#pragma unroll
        for (int m = 0; m < 4; ++m)
#pragma unroll
          for (int n = 0; n < 2; ++n)
#pragma unroll
            for (int j = 0; j < 4; ++j) {
              const int r = wr * 64 + m * 16 + fq * 4 + j;
              const int c = (bj * 128 + wc * 32 + n * 16 + fr) ^ (fq << 4);
              cs[r * 256 + c] = acc[ai][bj][m][n][j];
            }
      __syncthreads();
      epi_store<MODE>(swid, cs, brow + ai * HALF, bcol, e);
      __syncthreads();
    }
  }
#undef SA
#undef SB
#undef STAGE_A
#undef STAGE_B
#undef LDA
#undef LDB
#undef MMA
}

__device__ __forceinline__ bool tile_of(int step, int nM, int nN, int& pm, int& pn) {
  const int G = gridDim.x, b = blockIdx.x;
  const int ntiles = nM * nN, chunk = ntiles >> 3, nslots = G >> 3;
  const int xcd = b & 7, slot = b >> 3;
  const int L = step * nslots + slot;
  if (L >= chunk) return false;
  const int wgid = xcd * chunk + L;
  const int WGM = 4;
  const int nig = WGM * nN, gid = wgid / nig, fm = gid * WGM, gsz = min(nM - fm, WGM);
  pm = fm + ((wgid % nig) % gsz);
  pn = (wgid % nig) / gsz;
  return true;
}

struct ConvDesc { const float* src; h16* dst; };
__device__ __forceinline__ int conv_items(int layer) { return (layer & 1) ? (80 * 32 + 1024) : (84 * 32 + 1024); }
__device__ __forceinline__ ConvDesc conv_decode(const Params& p, int layer, int it, int& ldn) {
  h16* WT = (h16*)(p.ws + OFF_WT);
  h16* WO = (h16*)(p.ws + OFF_WO);
  const int il = layer >> 1;
  ConvDesc d;
  if (layer & 1) {
    if (it < 80 * 32) {
      int nt = it >> 5, kt = it & 31;
      ldn = 5120;
      d.src = p.odd_w_in + (size_t)il * 2048 * 5120 + (size_t)(kt * 64) * 5120 + nt * 64;
      d.dst = WT + (size_t)(nt * 64) * 2048 + kt * 64;
    } else {
      it -= 80 * 32;
      int nt = it >> 5, kt = it & 31;
      ldn = 2048;
      d.src = p.odd_w_out + (size_t)il * 2048 * 2048 + (size_t)(kt * 64) * 2048 + nt * 64;
      d.dst = WO + (size_t)(nt * 64) * 2048 + kt * 64;
    }
  } else {
    if (it < 84 * 32) {
      int nt = it >> 5, kt = it & 31;
      int srccol = nt * 64, dstrow = nt * 64;
      if (nt >= 68) { srccol = 5376 + (nt - 68) * 64; dstrow = 6400 + (nt - 68) * 64; }
      ldn = 6400;
      d.src = p.even_w_in + (size_t)il * 2048 * 6400 + (size_t)(kt * 64) * 6400 + srccol;
      d.dst = WT + (size_t)dstrow * 2048 + kt * 64;
    } else {
      it -= 84 * 32;
      int nt = it >> 5, kt = it & 31;
      ldn = 2048;
      d.src = p.even_w_out + (size_t)il * 2048 * 2048 + (size_t)(kt * 64) * 2048 + nt * 64;
      d.dst = WO + (size_t)(nt * 64) * 2048 + kt * 64;
    }
  }
  return d;
}
__device__ __forceinline__ void conv_run(const Params& p, const int swid, int layer, int first, int step, int count) {
  if (first >= count) return;
  float* tile = (float*)smem;
  const int tid = TIDX;
  const int kk = tid >> 4, n4 = tid & 15, nn = tid >> 3, kc = tid & 7;
  int ldn;
  ConvDesc d = conv_decode(p, layer, first, ldn);
  float4 r0 = *reinterpret_cast<const float4*>(d.src + (size_t)kk * ldn + n4 * 4);
  float4 r1 = *reinterpret_cast<const float4*>(d.src + (size_t)(kk + 32) * ldn + n4 * 4);
#pragma unroll 1
  for (int it = first; it < count; it += step) {
    ConvDesc dn = d;
    float4 q0 = r0, q1 = r1;
    if (it + step < count) {
      int ldn2;
      dn = conv_decode(p, layer, it + step, ldn2);
      q0 = *reinterpret_cast<const float4*>(dn.src + (size_t)kk * ldn2 + n4 * 4);
      q1 = *reinterpret_cast<const float4*>(dn.src + (size_t)(kk + 32) * ldn2 + n4 * 4);
    }
    tile[kk * 65 + n4 * 4 + 0] = r0.x; tile[kk * 65 + n4 * 4 + 1] = r0.y; tile[kk * 65 + n4 * 4 + 2] = r0.z; tile[kk * 65 + n4 * 4 + 3] = r0.w;
    tile[(kk + 32) * 65 + n4 * 4 + 0] = r1.x; tile[(kk + 32) * 65 + n4 * 4 + 1] = r1.y;
    tile[(kk + 32) * 65 + n4 * 4 + 2] = r1.z; tile[(kk + 32) * 65 + n4 * 4 + 3] = r1.w;
    __syncthreads();
    h16x8 o;
#pragma unroll
    for (int q = 0; q < 8; ++q) o[q] = (h16)tile[(kc * 8 + q) * 65 + nn];
    *reinterpret_cast<h16x8*>(d.dst + (size_t)nn * 2048 + kc * 8) = o;
    __syncthreads();
    d = dn; r0 = q0; r1 = q1;
  }
}

__device__ __forceinline__ void fold_tile(const Params& p, const int swid, int il, int tix) {
  const int pn = tix & 7, g = (tix >> 3) & 3, cs = tix >> 5;
  const h16* TWC = (const h16*)(p.ws + OFF_TWC) + (size_t)cs * 65536;
  const h16* WU = (const h16*)(p.ws + OFF_WU) + (size_t)il * 2048 * 1024 + g * 256;
  Epi e{};
  e.o0 = (h16*)(p.ws + OFF_WT) + (size_t)(4352 + cs * 1024 + g * 256) * 2048;
  gemm_tile<M_FOLD>(swid, TWC, TWC, 1 << 30, 256, WU, 1024, 256, 0, pn * 256, e);
}

__device__ __forceinline__ void phase0(const Params& p, const int swid) {
  const int G = gridDim.x, b = blockIdx.x, tid = TIDX;
  const int wid = tid >> 6, lane = tid & 63;
  if (b < 384) {
    float* sc = (float*)smem;
    float* part = (float*)(p.ws + OFF_PART);
    for (int it = b; it < 384; it += G) {
      const int l = it / 96, r = it % 96, kc = r / 12, cg = r % 12;
      __syncthreads();
      for (int i = tid; i < 9 * 256; i += NTHR) {
        const int c = i >> 8, k = kc * 256 + (i & 255);
        const float v = (c == 0) ? p.c_ctx[k] : p.c[(c - 1) * 2048 + k];
        sc[i] = siluf_(v);
      }
      __syncthreads();
      const int n = cg * 512 + tid;
      const float* W = p.mod_w + ((size_t)l * 2048 + kc * 256) * 6144 + n;
      float acc[9];
#pragma unroll
      for (int c = 0; c < 9; ++c) acc[c] = 0.f;
#pragma unroll 16
      for (int k = 0; k < 256; ++k) {
        const float w = W[(size_t)k * 6144];
#pragma unroll
        for (int c = 0; c < 9; ++c) acc[c] = fmaf(w, sc[c * 256 + k], acc[c]);
      }
      const float bias0 = (kc == 0) ? p.mod_b[(size_t)l * 6144 + n] : 0.f;
#pragma unroll
      for (int c = 0; c < 9; ++c) part[((size_t)(l * 8 + kc) * 9 + c) * 6144 + n] = acc[c] + bias0;
    }
    __syncthreads();
  }
  const int n_conv = conv_items(0);
  const int I_WU = n_conv, I_TWC = I_WU + 1024, I_TW2048 = I_TWC + 32, I_TW256 = I_TW2048 + 2048, I_ROPE = I_TW256 + 32,
            I_LW = I_ROPE + 1, I_CC = I_LW + 128, I_END = I_CC + 1024;
  conv_run(p, swid, 0, b, G, n_conv);
  for (int it = b; it < I_END; it += G) {
    if (it < n_conv) {
      continue;
    } else if (it < I_TWC) {
      int base = (it - I_WU) * 4096 + tid * 8;
      int il = base >> 21, rem = base & ((1 << 21) - 1), k = rem >> 10, c = rem & 1023;
      const float* s = p.even_w_in + ((size_t)il * 2048 + k) * 6400 + 4352 + c;
      float4 a = *reinterpret_cast<const float4*>(s), bb = *reinterpret_cast<const float4*>(s + 4);
      h16x8 o;
      o[0] = (h16)a.x; o[1] = (h16)a.y; o[2] = (h16)a.z; o[3] = (h16)a.w;
      o[4] = (h16)bb.x; o[5] = (h16)bb.y; o[6] = (h16)bb.z; o[7] = (h16)bb.w;
      *reinterpret_cast<h16x8*>((h16*)(p.ws + OFF_WU) + base) = o;
    } else if (it < I_TW2048) {
      int base = (it - I_TWC) * 4096 + tid * 8;
      int cs = base >> 16, f = (base >> 8) & 255, c0 = base & 255;
      h16x8 o;
#pragma unroll
      for (int q = 0; q < 8; ++q) {
        float x = (float)((f * (c0 + q)) & 255) * (1.f / 256.f);
        o[q] = (h16)(cs ? __builtin_amdgcn_sinf(x) : __builtin_amdgcn_cosf(x));
      }
      *reinterpret_cast<h16x8*>((h16*)(p.ws + OFF_TWC) + base) = o;
    } else if (it < I_TW256) {
      int base = (it - I_TW2048) * 4096 + tid * 8;
      int f = base >> 12, k0 = base & 4095;
      h16x8 o;
#pragma unroll
      for (int q = 0; q < 8; ++q) {
        int k = k0 + q;
        int sn = k >> 11, t = k & 2047;
        float x = (float)((f * t) & 2047) * (1.f / 2048.f);
        o[q] = (h16)(sn ? -__builtin_amdgcn_sinf(x) : __builtin_amdgcn_cosf(x));
      }
      *reinterpret_cast<h16x8*>((h16*)(p.ws + OFF_TW2048) + base) = o;
    } else if (it < I_ROPE) {
      int base = (it - I_TW256) * 4096 + tid * 8;
      int f = base >> 9, k0 = base & 511;
      h16x8 o;
#pragma unroll
      for (int q = 0; q < 8; ++q) {
        int k = k0 + q;
        int sn = k >> 8, t = k & 255;
        float x = (float)((f * t) & 255) * (1.f / 256.f);
        o[q] = (h16)(sn ? -__builtin_amdgcn_sinf(x) : __builtin_amdgcn_cosf(x));
      }
      *reinterpret_cast<h16x8*>((h16*)(p.ws + OFF_TW256) + base) = o;
    } else if (it < I_LW) {
      for (int i = tid; i < 1024; i += NTHR) {
        int pos = i >> 4, fi = i & 15;
        float inv = 1.0f / exp2f((float)fi * (13.287712379549449f / 16.f));
        float ang = (float)pos * inv;
        float x = ang * 0.15915494309189535f;
        x = x - floorf(x);
        ((float*)(p.ws + OFF_ROPE))[i * 2] = __builtin_amdgcn_cosf(x);
        ((float*)(p.ws + OFF_ROPE))[i * 2 + 1] = __builtin_amdgcn_sinf(x);
      }
    } else if (it >= I_CC) {
      int base = (it - I_CC) * 4096 + tid * 8;
      int which = base >= (int)CACHE_ELEMS;
      int off = base - which * (int)CACHE_ELEMS;
      const float* src = (which ? p.cache_v : p.cache_k) + off;
      float4 a = *reinterpret_cast<const float4*>(src), bb = *reinterpret_cast<const float4*>(src + 4);
      h16x8 o;
      o[0] = (h16)a.x; o[1] = (h16)a.y; o[2] = (h16)a.z; o[3] = (h16)a.w;
      o[4] = (h16)bb.x; o[5] = (h16)bb.y; o[6] = (h16)bb.z; o[7] = (h16)bb.w;
      *reinterpret_cast<h16x8*>((h16*)(p.ws + (which ? OFF_CV : OFF_CK)) + off) = o;
    } else {
      int ti = (it - I_LW) * 512 + tid;
      int kc = ti & 7, n = (ti >> 3) & 1023, combo = ti >> 13;
      int il = combo >> 2, type = (combo >> 1) & 1, dir = combo & 1;
      const float* src = (type ? p.even_a_up : p.even_w_up) + ((size_t)(il * 2 + dir) * 64 + kc * 8) * 1024 + n;
      h16x8 o;
#pragma unroll
      for (int q = 0; q < 8; ++q) o[q] = (h16)src[(size_t)q * 1024];
      *reinterpret_cast<h16x8*>((h16*)(p.ws + OFF_LW) + ((size_t)combo * 1024 + n) * 64 + kc * 8) = o;
    }
  }
}

__device__ __forceinline__ void norm_rows(const Params& p, const int swid, int l_done, int l_next) {
  const int tid = TIDX, wid = tid >> 6, lane = tid & 63;
  const float* mod = (const float*)(p.ws + OFF_PART);
  const h16* yout = (const h16*)(p.ws + OFF_C);
  h16* H = (h16*)(p.ws + OFF_H);
  const bool has_y = l_done >= 0, has_h = l_next < 4;
  float* par = (float*)smem;
  const int brow0 = blockIdx.x * 96;
  auto cond_of = [&](int row) -> int { return (row < NPR) ? 0 : 1 + ((row - NPR) >> 11); };
  const int c_first = cond_of(brow0), c_last = cond_of(brow0 + 95);
  __syncthreads();
  const int nset = (c_last != c_first) ? 2 : 1;
  for (int i = tid; i < nset * 2048; i += NTHR) {
    const int set = i >> 11, col = i & 2047;
    const int c = set ? c_last : c_first;
    float v1 = 0.f, v2 = 0.f, v3 = 0.f;
    auto mod_get = [&](int l, int idx) -> float {
      float sum = 0.f;
#pragma unroll
      for (int kc = 0; kc < 8; ++kc) sum += mod[((size_t)(l * 8 + kc) * 9 + c) * 6144 + idx];
      return sum;
    };
    if (has_y) v1 = mod_get(l_done, 4096 + col) * p.norm_post[(size_t)l_done * 2048 + col];
    if (has_h) {
      v2 = p.norm_pre[(size_t)l_next * 2048 + col] * (1.f + mod_get(l_next, 2048 + col));
      v3 = mod_get(l_next, col);
    }
    par[(set * 3 + 0) * 2048 + col] = v1;
    par[(set * 3 + 1) * 2048 + col] = v2;
    par[(set * 3 + 2) * 2048 + col] = v3;
  }
  __syncthreads();
  const int rbase = brow0 + wid * 12;
  auto row_ptr = [&](int row) -> const float* {
    if (l_done <= 0) return (row < NPR) ? (p.x_prompt + (size_t)row * 2048) : (p.x_sample + (size_t)(row - NPR) * 2048);
    return p.out + (size_t)row * 2048;
  };
  struct RowBuf { float4 x[8]; h16x4 y[8]; };
  auto load_row = [&](int row, RowBuf& rb) {
    const float* xin = row_ptr(row);
#pragma unroll
    for (int i = 0; i < 8; ++i) rb.x[i] = *reinterpret_cast<const float4*>(xin + i * 256 + lane * 4);
    if (has_y) {
#pragma unroll
      for (int i = 0; i < 8; ++i) rb.y[i] = *reinterpret_cast<const h16x4*>(yout + (size_t)row * 2048 + i * 256 + lane * 4);
    }
  };
  auto process = [&](int row, RowBuf& rb) {
    const float* ps = par + ((cond_of(row) == c_first) ? 0 : 3 * 2048) + lane * 4;
    if (has_y) {
      float ss = 0.f;
#pragma unroll
      for (int i = 0; i < 8; ++i)
#pragma unroll
        for (int e = 0; e < 4; ++e) { const float yv = (float)rb.y[i][e]; ss += yv * yv; }
      ss = wave_sum(ss);
      const float rstd = rsqrtf(ss * (1.f / 2048.f) + 1e-6f);
#pragma unroll
      for (int i = 0; i < 8; ++i) {
        const float4 q1 = *reinterpret_cast<const float4*>(ps + i * 256);
        rb.x[i].x += q1.x * ((float)rb.y[i][0] * rstd);
        rb.x[i].y += q1.y * ((float)rb.y[i][1] * rstd);
        rb.x[i].z += q1.z * ((float)rb.y[i][2] * rstd);
        rb.x[i].w += q1.w * ((float)rb.y[i][3] * rstd);
        *reinterpret_cast<float4*>(p.out + (size_t)row * 2048 + i * 256 + lane * 4) = rb.x[i];
      }
    }
    if (has_h) {
      float ss = 0.f;
#pragma unroll
      for (int i = 0; i < 8; ++i) ss += rb.x[i].x * rb.x[i].x + rb.x[i].y * rb.x[i].y + rb.x[i].z * rb.x[i].z + rb.x[i].w * rb.x[i].w;
      ss = wave_sum(ss);
      const float rstd = rsqrtf(ss * (1.f / 2048.f) + 1e-6f);
#pragma unroll
      for (int i = 0; i < 8; ++i) {
        const float4 q2 = *reinterpret_cast<const float4*>(ps + 2048 + i * 256);
        const float4 q3 = *reinterpret_cast<const float4*>(ps + 4096 + i * 256);
        h16x4 o;
        o[0] = (h16)(rb.x[i].x * rstd * q2.x + q3.x);
        o[1] = (h16)(rb.x[i].y * rstd * q2.y + q3.y);
        o[2] = (h16)(rb.x[i].z * rstd * q2.z + q3.z);
        o[3] = (h16)(rb.x[i].w * rstd * q2.w + q3.w);
        *reinterpret_cast<h16x4*>(H + (size_t)row * 2048 + i * 256 + lane * 4) = o;
      }
    }
  };
  RowBuf A, B;
  load_row(rbase, A);
#pragma unroll 1
  for (int k = 0; k < 12; k += 2) {
    load_row(rbase + k + 1, B);
    process(rbase + k, A);
    if (k + 2 < 12) load_row(rbase + k + 2, A);
    process(rbase + k + 1, B);
  }
  __syncthreads();
}

__device__ __forceinline__ void even_prep(const Params& p, const int swid, int il) {
  const int tid = TIDX, wid = tid >> 6, lane = tid & 63;
  const h16* PA = (const h16*)(p.ws + OFF_PA);
  h16* RS = (h16*)(p.ws + OFF_H);
  h16* KS = RS + NT1K;
  h16* Cb = (h16*)(p.ws + OFF_C);
  h16* VS = Cb + 4 * NT1K;
  float* RN = (float*)(p.ws + OFF_RN);
  const float* mu = p.even_mu + (size_t)il * 3328;
  const float* kkw = p.even_k_k + (size_t)il * 1024;
  h16* Alow = (h16*)smem;
  const int LDL = 264;
  const h16* LW = (const h16*)(p.ws + OFF_LW) + (size_t)il * 4 * 1024 * 64;
  for (int item = blockIdx.x; item < NT / 32; item += gridDim.x) {
    const int row0 = item * 32;
    {
      const int rbase = row0 + wid * 4;
      int T, t0;
      if (rbase < NPR) { T = 256; t0 = rbase & 255; } else { T = 2048; t0 = (rbase - NPR) & 2047; }
      const bool has_m1 = t0 > 0, has_p4 = (t0 + 4) < T;
      const h16* base = PA + (size_t)rbase * 3328;
      struct RowsIn { h16x8 x[6]; float4 m0, m1, k0, k1; };
      auto load_rows = [&](int ch, RowsIn& in) {
        const int c0 = ch * 8;
        in.x[0] = h16x8{}; in.x[5] = h16x8{};
        if (has_m1) in.x[0] = *reinterpret_cast<const h16x8*>(base - 3328 + c0);
#pragma unroll
        for (int i = 0; i < 4; ++i) in.x[i + 1] = *reinterpret_cast<const h16x8*>(base + (size_t)i * 3328 + c0);
        if (has_p4) in.x[5] = *reinterpret_cast<const h16x8*>(base + (size_t)4 * 3328 + c0);
        in.m0 = *reinterpret_cast<const float4*>(mu + c0);
        in.m1 = *reinterpret_cast<const float4*>(mu + c0 + 4);
        in.k0 = float4{0.f, 0.f, 0.f, 0.f}; in.k1 = in.k0;
        if (c0 >= 1024 && c0 < 2048) {
          in.k0 = *reinterpret_cast<const float4*>(kkw + c0 - 1024);
          in.k1 = *reinterpret_cast<const float4*>(kkw + c0 - 1020);
        }
      };
      auto compute = [&](int ch, const RowsIn& in) {
        const int c0 = ch * 8;
        const float mm[8] = {in.m0.x, in.m0.y, in.m0.z, in.m0.w, in.m1.x, in.m1.y, in.m1.z, in.m1.w};
        const float kq[8] = {in.k0.x, in.k0.y, in.k0.z, in.k0.w, in.k1.x, in.k1.y, in.k1.z, in.k1.w};
#pragma unroll
        for (int tt = 0; tt < 4; ++tt) {
          const int row = rbase + tt;
          float sv[8];
#pragma unroll
          for (int q = 0; q < 8; ++q) {
            float xcq = (float)in.x[tt + 1][q];
            sv[q] = xcq + mm[q] * (0.5f * ((float)in.x[tt][q] + (float)in.x[tt + 2][q]) - xcq);
          }
          if (c0 < 3072) {
            h16x8 o;
#pragma unroll
            for (int q = 0; q < 8; ++q) o[q] = (h16)sv[q];
            if (c0 < 1024) *reinterpret_cast<h16x8*>(RS + (size_t)row * 1024 + c0) = o;
            else if (c0 < 2048) {
              *reinterpret_cast<h16x8*>(KS + (size_t)row * 1024 + (c0 - 1024)) = o;
              float ssq = 0.f;
#pragma unroll
              for (int q = 0; q < 8; ++q) { float v = (float)o[q] * kq[q]; ssq += v * v; }
              ssq += __shfl_xor(ssq, 1);
              ssq += __shfl_xor(ssq, 2);
              ssq += __shfl_xor(ssq, 4);
              if ((lane & 7) == 0) RN[(size_t)row * 16 + ((c0 - 1024) >> 6)] = 1.f / fmaxf(sqrtf(ssq), 1e-12f);
            } else *reinterpret_cast<h16x8*>(VS + (size_t)row * 1024 + (c0 - 2048)) = o;
          } else {
            const int lc = c0 - 3072;
            h16x8 o;
#pragma unroll
            for (int q = 0; q < 8; ++q) o[q] = (h16)((lc < 128) ? tanhf(sv[q]) : sv[q]);
            *reinterpret_cast<h16x8*>(Alow + (wid * 4 + tt) * LDL + lc) = o;
          }
        }
      };
      RowsIn ra, rb;
      load_rows(lane, ra);
#pragma unroll 1
      for (int i = 0; i < 6; i += 2) {
        load_rows(lane + 64 * (i + 1), rb);
        compute(lane + 64 * i, ra);
        if (i + 2 < 6 || lane < 32) load_rows(lane + 64 * (i + 2), ra);
        compute(lane + 64 * (i + 1), rb);
      }
      if (lane < 32) compute(lane + 64 * 6, ra);
    }
    __syncthreads();
    {
      const int fr = lane & 15, fq = lane >> 4;
#pragma unroll 1
      for (int combo = 0; combo < 4; ++combo) {
        const int type = combo >> 1, dir = combo & 1;
        h16x8 af[2][2];
#pragma unroll
        for (int m = 0; m < 2; ++m)
#pragma unroll
          for (int ks = 0; ks < 2; ++ks)
            af[m][ks] = *reinterpret_cast<const h16x8*>(Alow + (m * 16 + fr) * LDL + type * 128 + dir * 64 + ks * 32 + fq * 8);
        const float* bias = (type ? p.even_a0 : p.even_w0) + (size_t)(il * 2 + dir) * 1024;
        h16* dst = Cb + (size_t)(type * 2 + dir) * NT1K;
#pragma unroll 1
        for (int nti = 0; nti < 8; ++nti) {
          const int n0 = (wid * 8 + nti) * 16;
          const h16* lw = LW + ((size_t)combo * 1024 + n0 + fr) * 64 + fq * 8;
          h16x8 b0 = *reinterpret_cast<const h16x8*>(lw), b1 = *reinterpret_cast<const h16x8*>(lw + 32);
          const float bs = bias[n0 + fr];
#pragma unroll
          for (int m = 0; m < 2; ++m) {
            f32x4 acc = {0.f, 0.f, 0.f, 0.f};
            acc = __builtin_amdgcn_mfma_f32_16x16x32_f16(af[m][0], b0, acc, 0, 0, 0);
            acc = __builtin_amdgcn_mfma_f32_16x16x32_f16(af[m][1], b1, acc, 0, 0, 0);
#pragma unroll
            for (int j = 0; j < 4; ++j) {
              float v = acc[j] + bs;
              float o = type ? sigmoidf_(v) : __expf(-0.6065306597126334f * sigmoidf_(v));
              dst[(size_t)(row0 + m * 16 + fq * 4 + j) * 1024 + n0 + fr] = (h16)o;
            }
          }
        }
      }
    }
    __syncthreads();
  }
}

template <int CTRL>
__device__ __forceinline__ float dpp_f(float v) {
  return __builtin_bit_cast(float, __builtin_amdgcn_update_dpp(0, __builtin_bit_cast(int, v), CTRL, 0xF, 0xF, true));
}
__device__ __forceinline__ float red8(float v) {
  v += dpp_f<0xB1>(v);
  v += dpp_f<0x4E>(v);
  v += dpp_f<0x141>(v);
  return v;
}
__device__ __forceinline__ void red8x2(float& a, float& b) {
  asm volatile(
      "s_nop 1\n\t"
      "v_add_f32_dpp %0, %0, %0 quad_perm:[1,0,3,2] row_mask:0xf bank_mask:0xf\n\t"
      "v_add_f32_dpp %1, %1, %1 quad_perm:[1,0,3,2] row_mask:0xf bank_mask:0xf\n\t"
      "s_nop 0\n\t"
      "v_add_f32_dpp %0, %0, %0 quad_perm:[2,3,0,1] row_mask:0xf bank_mask:0xf\n\t"
      "v_add_f32_dpp %1, %1, %1 quad_perm:[2,3,0,1] row_mask:0xf bank_mask:0xf\n\t"
      "s_nop 0\n\t"
      "v_add_f32_dpp %0, %0, %0 row_half_mirror row_mask:0xf bank_mask:0xf\n\t"
      "v_add_f32_dpp %1, %1, %1 row_half_mirror row_mask:0xf bank_mask:0xf\n\t"
      : "+v"(a), "+v"(b));
}

typedef __attribute__((ext_vector_type(2))) _Float16 h16x2;
constexpr int CS = 16;
constexpr int SC_RAW = 5 * CS * 128 + 256;
constexpr int SC_F32 = 6 * CS * 256;
constexpr int SC_TEAM = 2 * SC_RAW + 2 * SC_F32;

__device__ __forceinline__ void even_scan(const Params& p, const int swid, int il) {
  const int lane = lane_id_(), wid = swid;
  const int team = wid >> 2, part = wid & 3;
  const int bi = lane >> 3, bj = lane & 7;
  const int blk = blockIdx.x;
  const h16* RS = (const h16*)(p.ws + OFF_H);
  const h16* Cb = (const h16*)(p.ws + OFF_C);
  const float* RN = (const float*)(p.ws + OFF_RN);
  h16* Ob = (h16*)(p.ws + OFF_PA);
  char* traw = smem + team * SC_TEAM;
  char* tf32 = traw + 2 * SC_RAW;
  const int i0 = part * 16 + bi * 2, j0 = bj * 8;
  const int NIT = 2048 / CS;

  auto unit_of = [&](int it, int& T, int& rowbase, int& bidx, int& h, int& dir, int& chunk) -> bool {
    int unit;
    if (it >= NIT) return false;
    if (team == 0) { unit = blk; T = 2048; chunk = it; }
    else { if (it >= 4 * (256 / CS)) return false; unit = blk * 4 + it / (256 / CS); T = 256; chunk = it % (256 / CS); }
    dir = unit & 1; h = (unit >> 1) & 15; bidx = unit >> 5;
    rowbase = (team == 0) ? (NPR + bidx * 2048) : (bidx * 256);
    return true;
  };
  auto issue_chunk = [&](int it) {
    int T, rowbase, bidx, h, dir, chunk;
    if (!unit_of(it, T, rowbase, bidx, h, dir, chunk)) return;
    char* buf = traw + (it & 1) * SC_RAW;
    const int row0 = rowbase + (dir ? (T - CS - chunk * CS) : (chunk * CS));
#pragma unroll
    for (int m = 0; m < 3; ++m) {
      const int idx = part + 4 * m;
      if (idx < 5 * (CS / 8)) {
        const int arr = idx / (CS / 8), half = idx % (CS / 8);
        const h16* base = (arr == 0) ? RS : (arr == 1) ? (RS + NT1K) : (arr == 2) ? (Cb + (size_t)dir * NT1K)
                          : (arr == 3) ? (Cb + (size_t)(2 + dir) * NT1K) : (Cb + 4 * NT1K);
        const h16* src = base + (size_t)(row0 + half * 8 + (lane >> 3)) * 1024 + h * 64 + (lane & 7) * 8;
        __builtin_amdgcn_global_load_lds((const unsigned*)src, (unsigned*)(buf + arr * (CS * 128) + half * 1024), 16, 0, 0);
      } else if (idx == 5 * (CS / 8)) {
        const int r = lane < CS ? lane : CS - 1;
        const float* src = RN + (size_t)(row0 + r) * 16 + h;
        __builtin_amdgcn_global_load_lds((const unsigned*)src, (unsigned*)(buf + 5 * CS * 128), 4, 0, 0);
      }
    }
  };
  float kkc0 = 0.f, kkc1 = 0.f, kac0 = 0.f, kac1 = 0.f;
  auto prep_chunk = [&](int it) {
    int T, rowbase, bidx, h, dir, chunk;
    if (!unit_of(it, T, rowbase, bidx, h, dir, chunk)) return;
    const int sp = lane >> 5, cp = lane & 31;
    if (chunk == 0) {
      const float2 a = *reinterpret_cast<const float2*>(p.even_k_k + (size_t)il * 1024 + h * 64 + cp * 2);
      const float2 c = *reinterpret_cast<const float2*>(p.even_k_a + (size_t)il * 1024 + h * 64 + cp * 2);
      kkc0 = a.x; kkc1 = a.y; kac0 = c.x; kac1 = c.y;
      asm volatile("s_waitcnt vmcnt(0)" ::: "memory");
      asm volatile("" : "+v"(kkc0), "+v"(kkc1), "+v"(kac0), "+v"(kac1));
    }
    const char* raw = traw + (it & 1) * SC_RAW;
    char* f = tf32 + (it & 1) * SC_F32;
#pragma unroll
    for (int pass = 0; pass < CS / 8; ++pass) {
      const int s = (CS / 4) * part + 2 * pass + sp;
      const int r = dir ? (CS - 1 - s) : s;
      const h16x2 r2 = *reinterpret_cast<const h16x2*>(raw + r * 128 + cp * 4);
      const h16x2 k2 = *reinterpret_cast<const h16x2*>(raw + CS * 128 + r * 128 + cp * 4);
      const h16x2 w2 = *reinterpret_cast<const h16x2*>(raw + 2 * CS * 128 + r * 128 + cp * 4);
      const h16x2 a2 = *reinterpret_cast<const h16x2*>(raw + 3 * CS * 128 + r * 128 + cp * 4);
      const h16x2 v2 = *reinterpret_cast<const h16x2*>(raw + 4 * CS * 128 + r * 128 + cp * 4);
      const float rn = *reinterpret_cast<const float*>(raw + 5 * CS * 128 + r * 4);
      const float kf0 = (float)k2[0], kf1 = (float)k2[1], af0 = (float)a2[0], af1 = (float)a2[1];
      float2 kk, kka, kd, rr, ww, vv;
      kk.x = kf0 * (kkc0 * rn); kk.y = kf1 * (kkc1 * rn);
      kka.x = kk.x * af0; kka.y = kk.y * af1;
      kd.x = kf0 * fmaf(af0 - 1.f, kac0, 1.f); kd.y = kf1 * fmaf(af1 - 1.f, kac1, 1.f);
      rr.x = (float)r2[0]; rr.y = (float)r2[1];
      ww.x = (float)w2[0]; ww.y = (float)w2[1];
      vv.x = (float)v2[0]; vv.y = (float)v2[1];
      char* fo = f + s * 256 + cp * 8;
      *reinterpret_cast<float2*>(fo) = kk;
      *reinterpret_cast<float2*>(fo + CS * 256) = kka;
      *reinterpret_cast<float2*>(fo + 2 * CS * 256) = kd;
      *reinterpret_cast<float2*>(fo + 3 * CS * 256) = rr;
      *reinterpret_cast<float2*>(fo + 4 * CS * 256) = ww;
      *reinterpret_cast<float2*>(fo + 5 * CS * 256) = vv;
    }
  };

  f32x2 S2[2][4];
#pragma unroll
  for (int q = 0; q < 4; ++q) { S2[0][q] = f32x2{0.f, 0.f}; S2[1][q] = f32x2{0.f, 0.f}; }
  char* tob = smem + 2 * SC_TEAM + team * (2 * CS * 128);
  auto store_o = [&](int pit) {
    int T, rowbase, bidx, h, dir, chunk;
    if (pit < 0 || part >= CS / 8) return;
    if (!unit_of(pit, T, rowbase, bidx, h, dir, chunk)) return;
    const int row0 = rowbase + (dir ? (T - CS - chunk * CS) : (chunk * CS));
    const int r = part * 8 + (lane >> 3), pc = lane & 7;
    const h16x8 v = *reinterpret_cast<const h16x8*>(tob + ((pit & 1) * CS + r) * 128 + pc * 16);
    *reinterpret_cast<h16x8*>(Ob + (size_t)dir * NT1K + (size_t)(row0 + r) * 1024 + h * 64 + pc * 8) = v;
  };

  issue_chunk(0);
  issue_chunk(1);
  asm volatile("s_waitcnt vmcnt(0)" ::: "memory");
  __syncthreads();
  prep_chunk(0);
  __syncthreads();
#pragma unroll 1
  for (int it = 0; it < NIT; ++it) {
    store_o(it - 1);
    issue_chunk(it + 2);
    prep_chunk(it + 1);
    int T, rowbase, bidx, h, dir, chunk;
    if (unit_of(it, T, rowbase, bidx, h, dir, chunk)) {
      const int ci = h * 64 + i0;
      if (chunk == 0) {
        if (team == 0) {
          const float* st = p.state_wkv + ((((size_t)bidx * 2 + il) * 2 + dir) * 16 + h) * 4096;
#pragma unroll
          for (int a2 = 0; a2 < 2; ++a2) {
            float4 s0 = *reinterpret_cast<const float4*>(st + (size_t)(i0 + a2) * 64 + j0);
            float4 s1 = *reinterpret_cast<const float4*>(st + (size_t)(i0 + a2) * 64 + j0 + 4);
            S2[a2][0] = f32x2{s0.x, s0.y}; S2[a2][1] = f32x2{s0.z, s0.w};
            S2[a2][2] = f32x2{s1.x, s1.y}; S2[a2][3] = f32x2{s1.z, s1.w};
          }
          asm volatile("s_waitcnt vmcnt(0)" ::: "memory");
#pragma unroll
          for (int q = 0; q < 4; ++q) asm volatile("" : "+v"(S2[0][q]), "+v"(S2[1][q]));
        } else {
#pragma unroll
          for (int q = 0; q < 4; ++q) { S2[0][q] = f32x2{0.f, 0.f}; S2[1][q] = f32x2{0.f, 0.f}; }
        }
      }
      const char* f = tf32 + (it & 1) * SC_F32 + j0 * 4;
      const char* fv = tf32 + (it & 1) * SC_F32 + 5 * CS * 256 + i0 * 4;
      const int row0 = rowbase + (dir ? (T - CS - chunk * CS) : (chunk * CS));
      h16* Od = Ob + (size_t)dir * NT1K + (size_t)row0 * 1024 + ci;
      const int rstart = dir ? CS - 1 : 0, rstep = dir ? -1 : 1;
      struct FIn { float4 q[10]; float2 v; };
      auto ldstep = [&](int s) -> FIn {
        FIn in;
        const float4* q0 = reinterpret_cast<const float4*>(f + s * 256);
        constexpr int VS16 = CS * 16;
        in.q[0] = q0[0]; in.q[1] = q0[1]; in.q[2] = q0[VS16]; in.q[3] = q0[VS16 + 1]; in.q[4] = q0[2 * VS16]; in.q[5] = q0[2 * VS16 + 1];
        in.q[6] = q0[3 * VS16]; in.q[7] = q0[3 * VS16 + 1]; in.q[8] = q0[4 * VS16]; in.q[9] = q0[4 * VS16 + 1];
        in.v = *reinterpret_cast<const float2*>(fv + s * 256);
        return in;
      };
      FIn cur = ldstep(0);
#pragma unroll
      for (int s = 0; s < CS; ++s) {
        FIn nxt = ldstep(s < CS - 1 ? s + 1 : CS - 1);
        f32x2 kk[4], kka[4], kd[4], rv[4], wv[4];
#pragma unroll
        for (int h2 = 0; h2 < 2; ++h2) {
          float4 t;
          t = cur.q[0 + h2]; kk[2 * h2] = f32x2{t.x, t.y}; kk[2 * h2 + 1] = f32x2{t.z, t.w};
          t = cur.q[2 + h2]; kka[2 * h2] = f32x2{t.x, t.y}; kka[2 * h2 + 1] = f32x2{t.z, t.w};
          t = cur.q[4 + h2]; kd[2 * h2] = f32x2{t.x, t.y}; kd[2 * h2 + 1] = f32x2{t.z, t.w};
          t = cur.q[6 + h2]; rv[2 * h2] = f32x2{t.x, t.y}; rv[2 * h2 + 1] = f32x2{t.z, t.w};
          t = cur.q[8 + h2]; wv[2 * h2] = f32x2{t.x, t.y}; wv[2 * h2 + 1] = f32x2{t.z, t.w};
        }
        const float2 vin = cur.v;
        float sa[2];
#pragma unroll
        for (int a2 = 0; a2 < 2; ++a2) {
          f32x2 t = S2[a2][0] * kk[0];
          t += S2[a2][1] * kk[1];
          t += S2[a2][2] * kk[2];
          t += S2[a2][3] * kk[3];
          sa[a2] = t[0] + t[1];
        }
        red8x2(sa[0], sa[1]);
        float o[2];
#pragma unroll
        for (int a2 = 0; a2 < 2; ++a2) {
          const float va = a2 ? vin.y : vin.x;
          const float nsa = -sa[a2];
          f32x2 t;
#pragma unroll
          for (int q = 0; q < 4; ++q) {
            f32x2 u = kd[q] * va + kka[q] * nsa;
            S2[a2][q] = S2[a2][q] * wv[q] + u;
            if (q == 0) t = S2[a2][q] * rv[q]; else t += S2[a2][q] * rv[q];
          }
          o[a2] = t[0] + t[1];
        }
        red8x2(o[0], o[1]);
        {
          h16x2 ov;
          ov[0] = (h16)o[0]; ov[1] = (h16)o[1];
          *reinterpret_cast<h16x2*>(tob + ((it & 1) * CS + rstart + rstep * s) * 128 + i0 * 2) = ov;
        }
        cur = nxt;
      }
      if (team == 1 && chunk == 256 / CS - 1) {
        float* so = p.out + OUT_STATE + ((((size_t)bidx * 2 + il) * 2 + dir) * 16 + h) * 4096;
#pragma unroll
        for (int a2 = 0; a2 < 2; ++a2) {
          float4 s0 = {S2[a2][0][0], S2[a2][0][1], S2[a2][1][0], S2[a2][1][1]};
          float4 s1 = {S2[a2][2][0], S2[a2][2][1], S2[a2][3][0], S2[a2][3][1]};
          *reinterpret_cast<float4*>(so + (size_t)(i0 + a2) * 64 + j0) = s0;
          *reinterpret_cast<float4*>(so + (size_t)(i0 + a2) * 64 + j0 + 4) = s1;
        }
      }
    }
    asm volatile("s_waitcnt vmcnt(0) lgkmcnt(0)" ::: "memory");
    __builtin_amdgcn_s_barrier();
    asm volatile("" ::: "memory");
  }
  store_o(NIT - 1);
}

__device__ __forceinline__ void even_post(const Params& p, const int swid, int il) {
  const int tid = TIDX, wid = tid >> 6, lane = tid & 63;
  const h16* RS = (const h16*)(p.ws + OFF_H);
  const h16* KS = RS + NT1K;
  const h16* Cb = (const h16*)(p.ws + OFF_C);
  const h16* AF = Cb + 2 * NT1K;
  const h16* AB = Cb + 3 * NT1K;
  const h16* VS = Cb + 4 * NT1K;
  const h16* OF = (const h16*)(p.ws + OFF_PA);
  const h16* OB = OF + NT1K;
  h16* GA = (h16*)(p.ws + OFF_PB);
  const int c0 = (lane >> 2) * 64 + (lane & 3) * 16;
  float ka[16], rk[16], gw[16], gb[16];
#pragma unroll
  for (int q = 0; q < 4; ++q) {
    float4 t;
    t = *reinterpret_cast<const float4*>(p.even_k_a + (size_t)il * 1024 + c0 + q * 4); ka[q * 4] = t.x; ka[q * 4 + 1] = t.y; ka[q * 4 + 2] = t.z; ka[q * 4 + 3] = t.w;
    t = *reinterpret_cast<const float4*>(p.even_r_k + (size_t)il * 1024 + c0 + q * 4); rk[q * 4] = t.x; rk[q * 4 + 1] = t.y; rk[q * 4 + 2] = t.z; rk[q * 4 + 3] = t.w;
    t = *reinterpret_cast<const float4*>(p.even_gn_w + (size_t)il * 1024 + c0 + q * 4); gw[q * 4] = t.x; gw[q * 4 + 1] = t.y; gw[q * 4 + 2] = t.z; gw[q * 4 + 3] = t.w;
    t = *reinterpret_cast<const float4*>(p.even_gn_b + (size_t)il * 1024 + c0 + q * 4); gb[q * 4] = t.x; gb[q * 4 + 1] = t.y; gb[q * 4 + 2] = t.z; gb[q * 4 + 3] = t.w;
  }
#pragma unroll 1
  for (int row = blockIdx.x * 8 + wid; row < NT; row += gridDim.x * 8) {
    const size_t idx = (size_t)row * 1024 + c0;
    h16x8 of[2], ob[2], rs[2], ks[2], vs[2], af[2], ab[2], ga[2];
#pragma unroll
    for (int hh = 0; hh < 2; ++hh) {
      of[hh] = *reinterpret_cast<const h16x8*>(OF + idx + hh * 8);
      ob[hh] = *reinterpret_cast<const h16x8*>(OB + idx + hh * 8);
      rs[hh] = *reinterpret_cast<const h16x8*>(RS + idx + hh * 8);
      ks[hh] = *reinterpret_cast<const h16x8*>(KS + idx + hh * 8);
      vs[hh] = *reinterpret_cast<const h16x8*>(VS + idx + hh * 8);
      af[hh] = *reinterpret_cast<const h16x8*>(AF + idx + hh * 8);
      ab[hh] = *reinterpret_cast<const h16x8*>(AB + idx + hh * 8);
      ga[hh] = *reinterpret_cast<const h16x8*>(GA + idx + hh * 8);
    }
    float o[16];
    float s1 = 0.f, bon = 0.f;
#pragma unroll
    for (int q = 0; q < 16; ++q) {
      const int hh = q >> 3, e = q & 7;
      o[q] = (float)of[hh][e] + (float)ob[hh][e];
      s1 += o[q];
      const float am = 0.5f * ((float)af[hh][e] + (float)ab[hh][e]);
      bon += (float)rs[hh][e] * ((float)ks[hh][e] * (1.f + (am - 1.f) * ka[q])) * rk[q];
    }
    s1 += __shfl_xor(s1, 1); s1 += __shfl_xor(s1, 2);
    bon += __shfl_xor(bon, 1); bon += __shfl_xor(bon, 2);
    const float mean = s1 * (1.f / 64.f);
    float s2 = 0.f;
#pragma unroll
    for (int q = 0; q < 16; ++q) { o[q] -= mean; s2 += o[q] * o[q]; }
    s2 += __shfl_xor(s2, 1); s2 += __shfl_xor(s2, 2);
    const float rstd = rsqrtf(s2 * (1.f / 64.f) + 64e-5f);
    h16x8 out[2];
#pragma unroll
    for (int q = 0; q < 16; ++q) {
      const int hh = q >> 3, e = q & 7;
      const float gn = o[q] * rstd * gw[q] + gb[q];
      out[hh][e] = (h16)((gn + bon * (float)vs[hh][e]) * siluf_((float)ga[hh][e]));
    }
    *reinterpret_cast<h16x8*>(GA + idx) = out[0];
    *reinterpret_cast<h16x8*>(GA + idx + 8) = out[1];
  }
}

__device__ __forceinline__ void dft2_tiles(const Params& p, const int swid) {
  const h16* UT = (const h16*)(p.ws + OFF_PB) + NT1K;
  h16* GB = (h16*)(p.ws + OFF_PB) + NT1K + (size_t)NT * 2048;
  for (int it = blockIdx.x; it < 384; it += gridDim.x) {
    Epi e{};
    if (it < 256) {
      int mt = it & 7, g = (it >> 3) & 3, b = it >> 5;
      const h16* A = (const h16*)(p.ws + OFF_TW2048);
      const h16* Bt = UT + (size_t)16777216 + (size_t)b * 4194304 + (size_t)g * 256 * 4096;
      e.o0 = GB + (size_t)(NPR + b * 2048) * 1024;
      e.aux = g * 256;
      e.scale = 0.001381067932004975f;
      gemm_tile<M_DFT2>(swid, A, A, 1 << 30, 4096, Bt, 4096, 4096, mt * 256, 0, e);
    } else {
      int i2 = it - 256;
      int g = i2 & 3, b = i2 >> 2;
      const h16* A = (const h16*)(p.ws + OFF_TW256);
      const h16* Bt = UT + (size_t)b * 524288 + (size_t)g * 256 * 512;
      e.o0 = GB + (size_t)(b * 256) * 1024;
      e.aux = g * 256;
      e.scale = 0.00390625f;
      gemm_tile<M_DFT2>(swid, A, A, 1 << 30, 512, Bt, 512, 512, 0, 0, e);
    }
  }
}

__device__ __forceinline__ void attention(const Params& p, const int swid, int il) {
  const int tid = TIDX, wid = swid, lane = tid & 63;
  const int fr = lane & 15, fq = lane >> 4;
  const h16* Q = (const h16*)(p.ws + OFF_PA);
  const h16* KB = (const h16*)(p.ws + OFF_PB);
  const h16* VB = KB + (size_t)NT * 512;
  const h16* GT = KB + NT1K;
  h16* Y = (h16*)(p.ws + OFF_H);
  h16* Ks = (h16*)smem;
  h16* Vt = Ks + 128 * 72;
  h16* Qs = Vt + 64 * 136;
  constexpr int LDK = 72, LDV = 136;
#pragma unroll 1
  for (int item = blockIdx.x; item < 1536; item += gridDim.x) {
    bool isample;
    int seq, kvh, qb, rowbase, nchunk;
    if (item < 1024) { isample = true; qb = item & 15; kvh = (item >> 4) & 7; seq = item >> 7; rowbase = NPR + seq * 2048; nchunk = 5; }
    else { int i2 = item - 1024; isample = false; qb = i2 & 1; kvh = (i2 >> 1) & 7; seq = i2 >> 4; rowbase = seq * 256; nchunk = 2; }
    const int qrow = rowbase + qb * 128 + wid * 16;
    __syncthreads();
#pragma unroll
    for (int g = 0; g < 4; ++g)
#pragma unroll
      for (int it = 0; it < 2; ++it) {
        int piece = lane + it * 64;
        int r = piece >> 3, d0 = (piece & 7) * 8;
        h16x8 v = *reinterpret_cast<const h16x8*>(Q + (size_t)(qrow + r) * 2048 + kvh * 256 + g * 64 + d0);
        *reinterpret_cast<h16x8*>(Qs + (g * 128 + wid * 16 + r) * LDK + d0) = v;
      }
    const h16* qbase = Qs + (wid * 16 + fr) * LDK + fq * 8;
    const h16* kbase = Ks + fr * LDK + fq * 8;
    const h16* vbase = Vt + fr * LDV + fq * 4;
    float mx[4], sinkv[4];
#pragma unroll
    for (int g = 0; g < 4; ++g) { sinkv[g] = p.odd_sink[il * 32 + kvh * 4 + g] * 1.4426950408889634f; mx[g] = sinkv[g]; }
    const int qi = wid * 16 + fr;

    const h16* CK = (const h16*)(p.ws + OFF_CK);
    const h16* CV = (const h16*)(p.ws + OFF_CV);
    auto chunk = [&](int ch, bool& from_cache, int& krow, int& lo, int& hi) -> bool {
      from_cache = false; lo = -100000; hi = 100000; krow = 0;
      if (isample) {
        if (ch < 3) {
          int blk = qb - 1 + ch;
          if (blk < 0 || blk > 15) return false;
          krow = rowbase + blk * 128;
          if (ch == 0) lo = qi;
          if (ch == 2) hi = qi;
        } else { from_cache = true; krow = (ch - 3) * 128; }
      } else krow = rowbase + ch * 128;
      return true;
    };
    auto next_stage = [&](int st) -> int {
      for (++st; st < 2 * nchunk; ++st) {
        bool fc; int kr, lo, hi;
        if (chunk(st % nchunk, fc, kr, lo, hi)) return st;
      }
      return 2 * nchunk;
    };
    h16x8 pk[2], pv[2];
    auto fetch = [&](int st) {
      bool from_cache; int krow, lo, hi;
      chunk(st % nchunk, from_cache, krow, lo, hi);
      const bool withV = st >= nchunk;
#pragma unroll
      for (int it = 0; it < 2; ++it) {
        int piece = tid + it * 512;
        asm volatile("" : "+v"(piece));
        int key = piece >> 3, d0 = (piece & 7) * 8;
        const h16* ks; const h16* vs;
        if (from_cache) {
          size_t off = ((((size_t)seq * 2 + il) * 256 + krow + key) * 8 + kvh) * 64 + d0;
          ks = CK + off; vs = CV + off;
        } else {
          size_t off = (size_t)(krow + key) * 512 + kvh * 64 + d0;
          ks = KB + off; vs = VB + off;
        }
        pk[it] = *reinterpret_cast<const h16x8*>(ks);
        if (withV) {
          const int vkey = piece & 127, vd0 = (piece >> 7) * 8;
          const h16* vs2 = from_cache ? (CV + ((((size_t)seq * 2 + il) * 256 + krow + vkey) * 8 + kvh) * 64 + vd0)
                                      : (VB + (size_t)(krow + vkey) * 512 + kvh * 64 + vd0);
          pv[it] = *reinterpret_cast<const h16x8*>(vs2);
        }
      }
    };
    auto commit = [&](int st) {
      const bool withV = st >= nchunk;
#pragma unroll
      for (int it = 0; it < 2; ++it) {
        int piece = tid + it * 512;
        int key = piece >> 3, d0 = (piece & 7) * 8;
        *reinterpret_cast<h16x8*>(Ks + key * LDK + d0) = pk[it];
        if (withV) {
          const int vkey = piece & 127, vd0 = (piece >> 7) * 8;
#pragma unroll
          for (int q = 0; q < 8; ++q) Vt[(vd0 + q) * LDV + vkey] = pv[it][q];
        }
      }
    };

    int st = next_stage(nchunk - 1);
    fetch(st);
    f32x4 Lacc[4];
#pragma unroll
    for (int g = 0; g < 4; ++g) Lacc[g] = f32x4{0.f, 0.f, 0.f, 0.f};
    const h16x8 ones8 = {(h16)1.f, (h16)1.f, (h16)1.f, (h16)1.f, (h16)1.f, (h16)1.f, (h16)1.f, (h16)1.f};
    f32x4 O[4][4];
#pragma unroll
    for (int g = 0; g < 4; ++g)
#pragma unroll
      for (int n = 0; n < 4; ++n) O[g][n] = f32x4{0.f, 0.f, 0.f, 0.f};
#pragma unroll 1
    while (st < 2 * nchunk) {
      bool from_cache; int krow, lo, hi;
      chunk(st % nchunk, from_cache, krow, lo, hi);
      const bool masked = isample && ((st % nchunk) == 0 || (st % nchunk) == 2);
      __syncthreads();
      commit(st);
      __syncthreads();
      const int nst = next_stage(st);
      if (nst < 2 * nchunk) fetch(nst);
      {
        const int cidx2 = st % nchunk;
        const int k2lo = (masked && cidx2 == 0) ? (wid >> 1) : 0;
        const int k2hi = (masked && cidx2 == 2) ? (wid >> 1) : 3;
#pragma unroll 1
        for (int k2 = k2lo; k2 <= k2hi; ++k2) {
          h16x8 vf[4];
#pragma unroll
          for (int n = 0; n < 4; ++n) {
            h16x4 lo4 = *reinterpret_cast<const h16x4*>(vbase + n * 16 * LDV + k2 * 32);
            h16x4 hi4 = *reinterpret_cast<const h16x4*>(vbase + n * 16 * LDV + k2 * 32 + 16);
            vf[n] = h16x8{lo4[0], lo4[1], lo4[2], lo4[3], hi4[0], hi4[1], hi4[2], hi4[3]};
          }
          h16x8 ka[2][2];
#pragma unroll
          for (int tt = 0; tt < 2; ++tt)
#pragma unroll
            for (int ks = 0; ks < 2; ++ks)
              ka[tt][ks] = *reinterpret_cast<const h16x8*>(kbase + (k2 * 32 + tt * 16) * LDK + ks * 32);
#pragma unroll
          for (int g = 0; g < 4; ++g) {
            const h16x8 q0 = *reinterpret_cast<const h16x8*>(qbase + g * 128 * LDK);
            const h16x8 q1 = *reinterpret_cast<const h16x8*>(qbase + g * 128 * LDK + 32);
            float sv[8];
#pragma unroll
            for (int tt = 0; tt < 2; ++tt) {
              f32x4 sc = {0.f, 0.f, 0.f, 0.f};
              sc = __builtin_amdgcn_mfma_f32_16x16x32_f16(ka[tt][0], q0, sc, 0, 0, 0);
              sc = __builtin_amdgcn_mfma_f32_16x16x32_f16(ka[tt][1], q1, sc, 0, 0, 0);
              if (masked) {
                asm volatile("");
#pragma unroll
                for (int j = 0; j < 4; ++j) {
                  const int kj = k2 * 32 + tt * 16 + fq * 4 + j;
                  sv[tt * 4 + j] = (kj >= lo && kj <= hi) ? sc[j] : -1e30f;
                }
              } else {
#pragma unroll
                for (int j = 0; j < 4; ++j) sv[tt * 4 + j] = sc[j];
              }
            }
            float smax = fmaxf(fmaxf(fmaxf(sv[0], sv[1]), fmaxf(sv[2], sv[3])), fmaxf(fmaxf(sv[4], sv[5]), fmaxf(sv[6], sv[7])));
            if (__any(smax > mx[g] + 8.f)) {
              smax = fmaxf(smax, __shfl_xor(smax, 16));
              smax = fmaxf(smax, __shfl_xor(smax, 32));
              const float mnew = fmaxf(mx[g], smax);
              const float alpha = __builtin_amdgcn_exp2f(mx[g] - mnew);
              mx[g] = mnew;
#pragma unroll
              for (int j = 0; j < 4; ++j) {
                const float al = __shfl(alpha, fq * 4 + j);
                Lacc[g][j] *= al;
#pragma unroll
                for (int n = 0; n < 4; ++n) O[g][n][j] *= al;
              }
            }
            float pe[8];
#pragma unroll
            for (int i = 0; i < 8; ++i) pe[i] = __builtin_amdgcn_exp2f(sv[i] - mx[g]);
            union { unsigned u[4]; h16x8 h; } pfu;
#pragma unroll
            for (int q = 0; q < 4; ++q) {
              auto pk2 = __builtin_amdgcn_cvt_pkrtz(pe[2 * q], pe[2 * q + 1]);
              pfu.u[q] = __builtin_bit_cast(unsigned, pk2);
            }
            const h16x8 pf = pfu.h;
            Lacc[g] = __builtin_amdgcn_mfma_f32_16x16x32_f16(pf, ones8, Lacc[g], 0, 0, 0);
#pragma unroll
            for (int n = 0; n < 4; ++n) O[g][n] = __builtin_amdgcn_mfma_f32_16x16x32_f16(pf, vf[n], O[g][n], 0, 0, 0);
          }
        }
      }
      st = nst;
    }
#pragma unroll
    for (int g = 0; g < 4; ++g) {
      const float sterm = __builtin_amdgcn_exp2f(sinkv[g] - mx[g]);
#pragma unroll
      for (int j = 0; j < 4; ++j) {
        const float li = __builtin_amdgcn_rcpf(Lacc[g][j] + __shfl(sterm, fq * 4 + j));
        h16* srow = Qs + (g * 128 + wid * 16 + fq * 4 + j) * LDK + fr;
#pragma unroll
        for (int n = 0; n < 4; ++n) srow[n * 16] = (h16)(O[g][n][j] * li);
      }
    }
    {
      const int q2 = lane >> 2, g2 = lane & 3;
      const int row = qrow + q2;
      const h16* src = Qs + (g2 * 128 + wid * 16 + q2) * LDK;
      const size_t goff = (size_t)row * 2048 + (kvh * 4 + g2) * 64;
#pragma unroll
      for (int e = 0; e < 8; ++e) {
        const h16x8 ov = *reinterpret_cast<const h16x8*>(src + e * 8);
        const h16x8 gv = *reinterpret_cast<const h16x8*>(GT + goff + e * 8);
        h16x8 yv;
#pragma unroll
        for (int q = 0; q < 8; ++q) yv[q] = (h16)((float)ov[q] * siluf_((float)gv[q]));
        *reinterpret_cast<h16x8*>(Y + goff + e * 8) = yv;
      }
    }
  }
  __syncthreads();
}

__device__ __forceinline__ void gemm_even_in(const Params& p, const int swid, int il) {
  const h16* H = (const h16*)(p.ws + OFF_H);
  const h16* WT = (const h16*)(p.ws + OFF_WT);
  Epi e{};
  e.o0 = (h16*)(p.ws + OFF_PA);
  e.o1 = (h16*)(p.ws + OFF_PB);
  e.o2 = (h16*)(p.ws + OFF_PB) + NT1K;
  e.o3 = (h16*)(p.ws + OFF_PB) + NT1K + (size_t)NT * 2048;
  e.il = il;
  for (int step = 0;; ++step) {
    int pm, pn;
    if (!tile_of(step, 96, 29, pm, pn)) break;
    gemm_tile<M_EVEN_IN>(swid, H, H, 1 << 30, 2048, WT, 2048, 2048, pm * 256, pn * 256, e);
  }
}
__device__ __forceinline__ void gemm_odd_in(const Params& p, const int swid, int il) {
  const h16* H = (const h16*)(p.ws + OFF_H);
  const h16* WT = (const h16*)(p.ws + OFF_WT);
  Epi e{};
  e.o0 = (h16*)(p.ws + OFF_PA);
  e.o1 = (h16*)(p.ws + OFF_PB);
  e.o2 = (h16*)(p.ws + OFF_PB) + (size_t)NT * 512;
  e.o3 = (h16*)(p.ws + OFF_PB) + NT1K;
  e.f0 = p.out + OUT_K;
  e.f1 = p.out + OUT_V;
  e.rope = (const float*)(p.ws + OFF_ROPE);
  e.il = il;
  for (int step = 0;; ++step) {
    int pm, pn;
    if (!tile_of(step, 96, 20, pm, pn)) break;
    gemm_tile<M_ODD_IN>(swid, H, H, 1 << 30, 2048, WT, 2048, 2048, pm * 256, pn * 256, e);
  }
}
__device__ __forceinline__ void gemm_out(const Params& p, const int swid, bool even) {
  const h16* WO = (const h16*)(p.ws + OFF_WO);
  Epi e{};
  e.o0 = (h16*)(p.ws + OFF_C);
  const h16* A0;
  const h16* A1;
  int ksplit, lda;
  if (even) { A0 = (const h16*)(p.ws + OFF_PB); A1 = A0 + NT1K + (size_t)NT * 2048; ksplit = 16; lda = 1024; }
  else { A0 = (const h16*)(p.ws + OFF_H); A1 = A0; ksplit = 1 << 30; lda = 2048; }
  for (int step = 0;; ++step) {
    int pm, pn;
    if (!tile_of(step, 96, 8, pm, pn)) break;
    gemm_tile<M_OUT_F32>(swid, A0, A1, ksplit, lda, WO, 2048, 2048, pm * 256, pn * 256, e);
  }
}

constexpr int NPHASE = 22;
__device__ __forceinline__ void phase_decode(int ph, int& kind, int& layer) {
  if (ph < 2) { kind = ph; layer = 0; return; }
  int q = ph - 2;
  if (q < 6) { layer = 0; kind = 2 + q; if (q >= 4) kind = 6 + (q - 4); return; }
  q -= 6;
  if (q < 4) { layer = 1; kind = (q == 0) ? 8 : (q == 1) ? 9 : (q == 2) ? 6 : 7; return; }
  q -= 4;
  if (q < 6) { layer = 2; kind = 2 + q; if (q >= 4) kind = 6 + (q - 4); return; }
  q -= 6;
  layer = 3;
  kind = (q == 0) ? 8 : (q == 1) ? 9 : (q == 2) ? 6 : 7;
}

__global__ void __launch_bounds__(NTHR, 2) mega(Params p, int ph_lo, int ph_hi) {
  cg::grid_group grid = cg::this_grid();
  const int swid = __builtin_amdgcn_readfirstlane((int)(__builtin_amdgcn_workitem_id_x() >> 6));
  const bool leader_thread = (__builtin_amdgcn_workitem_id_x() == 0);
  volatile LAS unsigned* xst = (volatile LAS unsigned*)(smem + 148480);
  if (leader_thread) { xst[0] = 0u; xst[1] = 0u; }
  __syncthreads();
  XcdBarrier xb;
  xb.bar = (unsigned*)(p.ws + OFF_BAR); xb.x = xb_xcc_id(); xb.st = xst;
  if (leader_thread) (void)xb_add(&xb.bar[XB_XCNT(xb.x)], 1u);
  for (int ph = ph_lo; ph < ph_hi; ++ph) {
    int kind, layer;
    phase_decode(ph, kind, layer);
    const int il = layer >> 1;
#ifdef PROBE_KIND
    if (kind == PROBE_KIND) {
      switch (kind) {
        case 2: gemm_even_in(p, swid, il); break;
        case 3: even_prep(p, swid, il); break;
        case 4: even_scan(p, swid, il); break;
        case 6: gemm_out(p, swid, (layer & 1) == 0); break;
        case 8: gemm_odd_in(p, swid, il); break;
        case 9: attention(p, swid, il); break;
      }
      grid.sync();
    }
#endif
    switch (kind) {
      case 0: phase0(p, swid); break;
      case 1:
        for (int t = blockIdx.x; t < 64; t += gridDim.x) fold_tile(p, swid, 0, t);
        norm_rows(p, swid, -1, 0);
        break;
      case 2: gemm_even_in(p, swid, il); break;
      case 3: dft2_tiles(p, swid); even_prep(p, swid, il); break;
      case 4: even_scan(p, swid, il); break;
      case 5: even_post(p, swid, il); break;
      case 6: gemm_out(p, swid, (layer & 1) == 0); break;
      case 7: {
        if (layer < 3) {
          const int nl = layer + 1;
          if ((nl & 1) == 0)
            for (int t = blockIdx.x; t < 64; t += gridDim.x) fold_tile(p, swid, nl >> 1, t);
          const int nc = conv_items(nl);
          conv_run(p, swid, nl, blockIdx.x, gridDim.x, nc);
        }
        norm_rows(p, swid, layer, layer + 1);
      } break;
      case 8: gemm_odd_in(p, swid, il); break;
      case 9: attention(p, swid, il); break;
    }
    if (ph + 1 < ph_hi) { if (ph == 0) grid.sync(); else xcd_barrier(xb, leader_thread); }
  }
}

extern "C" void kernel_launch(void* const* d_in, const int* in_sizes, int n_in, void* d_out, int out_size, void* d_ws,
                              size_t ws_size, hipStream_t stream) {
  Params p{};
  const float** pp = (const float**)&p;
  for (int i = 0; i < 26; ++i) pp[i] = (const float*)d_in[i];
  p.out = (float*)d_out;
  p.ws = (char*)d_ws;
  static int grid_blocks = 0;
  if (!grid_blocks) {
    hipFuncSetAttribute((const void*)mega, hipFuncAttributeMaxDynamicSharedMemorySize, (int)SMEM_BYTES);
    int dev = 0, cus = 0, per_cu = 0;
    hipGetDevice(&dev);
    hipDeviceGetAttribute(&cus, hipDeviceAttributeMultiprocessorCount, dev);
    hipOccupancyMaxActiveBlocksPerMultiprocessor(&per_cu, mega, NTHR, SMEM_BYTES);
    if (per_cu < 1) per_cu = 1;
    if (per_cu > 1) per_cu = 1;
    grid_blocks = 256;
    if (ws_size < WS_TOTAL) fprintf(stderr, "workspace too small: %zu < %zu\n", ws_size, WS_TOTAL);
  }
#if COOP
  (void)hipMemsetAsync((char*)d_ws + OFF_BAR, 0, XCD_BAR_WORDS_C * 4, stream);
  int lo = 0, hi = NPHASE;
  void* args[] = {&p, &lo, &hi};
  hipError_t e = hipLaunchCooperativeKernel((void*)mega, dim3(grid_blocks), dim3(NTHR), args, SMEM_BYTES, stream);
  if (e != hipSuccess) fprintf(stderr, "cooperative launch failed: %s (grid %d)\n", hipGetErrorString(e), grid_blocks);
#else
  for (int ph = 0; ph < NPHASE; ++ph) mega<<<grid_blocks, NTHR, SMEM_BYTES, stream>>>(p, ph, ph + 1);
#endif
}
```

```cpp
#include <hip/hip_runtime.h>
#include <hip/hip_fp16.h>
#include <hip/hip_cooperative_groups.h>
#include <cstdio>
namespace cg = cooperative_groups;

typedef _Float16 h16;
typedef __attribute__((ext_vector_type(8))) _Float16 h16x8;
typedef __attribute__((ext_vector_type(4))) _Float16 h16x4;
typedef __attribute__((ext_vector_type(4))) float f32x4;
typedef __attribute__((ext_vector_type(2))) float f32x2;

#ifndef COOP
#define COOP 1
#endif

constexpr int NT = 24576;
constexpr int NPR = 8192;
constexpr int DM = 2048;
constexpr int NTHR = 512;
constexpr size_t SMEM_BYTES = 148480 + 16;
constexpr size_t XCD_BAR_WORDS_C = 3456;

constexpr size_t SZ_WT = (size_t)7424 * 2048 * 2;
constexpr size_t OFF_WT = 0;
constexpr size_t OFF_WO = OFF_WT + SZ_WT;
constexpr size_t OFF_WU = OFF_WO + (size_t)2048 * 2048 * 2;
constexpr size_t OFF_TWC = OFF_WU + (size_t)2 * 2048 * 1024 * 2;
constexpr size_t OFF_TW2048 = OFF_TWC + (size_t)2 * 256 * 256 * 2;
constexpr size_t OFF_TW256 = OFF_TW2048 + (size_t)2048 * 4096 * 2;
constexpr size_t OFF_MOD = OFF_TW256 + (size_t)256 * 512 * 2;
constexpr size_t OFF_ROPE = OFF_MOD + (size_t)4 * 9 * 6144 * 4;
constexpr size_t OFF_LW = OFF_ROPE + (size_t)64 * 16 * 2 * 4;
constexpr size_t OFF_RN = OFF_LW + (size_t)8 * 1024 * 64 * 2;
constexpr size_t OFF_H = OFF_RN + (size_t)NT * 16 * 4;
constexpr size_t OFF_PA = OFF_H + (size_t)NT * 2048 * 2;
constexpr size_t OFF_PB = OFF_PA + (size_t)NT * 3328 * 2;
constexpr size_t OFF_C = OFF_PB + (size_t)NT * 4096 * 2;
constexpr size_t WS_NEED = OFF_C + (size_t)NT * 1024 * 2 * 5;
constexpr size_t OFF_BAR = WS_NEED;
constexpr size_t OFF_CK = OFF_BAR + 16384;
constexpr size_t CACHE_ELEMS = (size_t)8 * 2 * 256 * 512;
constexpr size_t OFF_CV = OFF_CK + CACHE_ELEMS * 2;
constexpr size_t OFF_PART = OFF_CV + CACHE_ELEMS * 2;
constexpr size_t WS_TOTAL = OFF_PART + (size_t)4 * 8 * 9 * 6144 * 4;
constexpr size_t NT1K = (size_t)NT * 1024;

constexpr size_t OUT_STATE = (size_t)NT * 2048;
constexpr size_t OUT_K = OUT_STATE + (size_t)32 * 2 * 2 * 16 * 64 * 64;
constexpr size_t OUT_V = OUT_K + (size_t)32 * 2 * 256 * 512;

struct Params {
  const float *x_prompt, *x_sample, *c, *state_wkv, *cache_k, *cache_v, *c_ctx, *mod_w, *mod_b, *norm_pre, *norm_post;
  const float *even_w_in, *even_mu, *even_w0, *even_w_up, *even_a0, *even_a_up, *even_k_k, *even_k_a, *even_r_k, *even_gn_w,
      *even_gn_b, *even_w_out;
  const float *odd_w_in, *odd_sink, *odd_w_out;
  float* out;
  char* ws;
};

extern __shared__ __attribute__((aligned(16))) char smem[];
__device__ __forceinline__ int lane_id_() {
  int l;
  asm volatile("v_mbcnt_lo_u32_b32 %0, -1, 0\n\tv_mbcnt_hi_u32_b32 %0, -1, %0" : "=v"(l));
  return l;
}
#define TIDX (swid * 64 + lane_id_())


__device__ __forceinline__ float wave_sum(float v) {
#pragma unroll
  for (int o = 32; o >= 1; o >>= 1) v += __shfl_xor(v, o);
  return v;
}
__device__ __forceinline__ float sigmoidf_(float x) { return __builtin_amdgcn_rcpf(1.f + __expf(-x)); }
__device__ __forceinline__ float siluf_(float x) { return x * __builtin_amdgcn_rcpf(1.f + __expf(-x)); }


#define XB_TMO      128
#define XB_XCNT(j)  (256  + 64 * (j))
#define XB_XSUB(j)  (1280 + 64 * (j))
#define XB_XGEN(j)  (2304 + 64 * (j))
#define XB_TOP      3328
#define XB_TOPGEN   3392
#define XCD_BAR_WORDS 3456
#define XB_SPIN_CAP (1u << 18)
#define LAS __attribute__((address_space(3)))
__device__ __forceinline__ unsigned xb_ld(unsigned* p) { return __hip_atomic_load(p, __ATOMIC_RELAXED, __HIP_MEMORY_SCOPE_AGENT); }
__device__ __forceinline__ unsigned xb_add(unsigned* p, unsigned v) { return __hip_atomic_fetch_add(p, v, __ATOMIC_RELAXED, __HIP_MEMORY_SCOPE_AGENT); }
__device__ __forceinline__ unsigned xb_xcc_id() { return (unsigned)__builtin_amdgcn_s_getreg((3 << 11) | 20) & 0xFu; }
#define XB_SPIN(cond, bar) do { unsigned _sp = 0; while (cond) { __builtin_amdgcn_s_sleep(1); \
    if ((++_sp & 255u) == 0u) { if (xb_ld(&(bar)[XB_TMO])) break; if (_sp > XB_SPIN_CAP) { atomicAdd(&(bar)[XB_TMO], 1u); break; } } } } while (0)
struct XcdBarrier { unsigned* bar; unsigned x; volatile LAS unsigned* st; };
__device__ __forceinline__ void xcd_barrier_complete(unsigned* bar, unsigned x, unsigned& nloc, unsigned& nx) {
  const unsigned G = gridDim.x;
  unsigned sum, cnt, mine, sp = 0u;
  for (;;) {
    sum = 0u; cnt = 0u; mine = 0u;
#pragma unroll
    for (unsigned j = 0; j < 16; ++j) { const unsigned c = xb_ld(&bar[XB_XCNT(j)]); sum += c; cnt += (c > 0u) ? 1u : 0u; mine = (j == x) ? c : mine; }
    if (sum == G) break;
    __builtin_amdgcn_s_sleep(1);
    if ((++sp & 255u) == 0u) { if (xb_ld(&bar[XB_TMO])) break; if (sp > XB_SPIN_CAP) { atomicAdd(&bar[XB_TMO], 1u); break; } }
  }
  nloc = mine > 0u ? mine : 1u; nx = cnt > 0u ? cnt : 1u;
}
__device__ __forceinline__ void xcd_barrier(const XcdBarrier& b, const bool leader_thread) {
  asm volatile("s_waitcnt vmcnt(0)" ::: "memory");
  __syncthreads();
  if (leader_thread) {
    unsigned* bar = b.bar;
    __builtin_amdgcn_s_waitcnt(0);
    unsigned nloc = b.st[0], nx = b.st[1];
    if (nloc == 0u) { xcd_barrier_complete(bar, b.x, nloc, nx); b.st[0] = nloc; b.st[1] = nx; }
    const unsigned old = xb_add(&bar[XB_XSUB(b.x)], 1u);
    const unsigned gen = old / nloc;
    if (old + 1u == (gen + 1u) * nloc) {
      __builtin_amdgcn_fence(__ATOMIC_RELEASE, "agent");
      asm volatile("s_waitcnt vmcnt(0)" ::: "memory");
      const unsigned og = xb_add(&bar[XB_TOP], 1u);
      const unsigned tg = og / nx;
      if (og + 1u == (tg + 1u) * nx) xb_add(&bar[XB_TOPGEN], 1u);
      else XB_SPIN(xb_ld(&bar[XB_TOPGEN]) == tg, bar);
      __builtin_amdgcn_fence(__ATOMIC_ACQUIRE, "agent");
      xb_add(&bar[XB_XGEN(b.x)], 1u);
      asm volatile("s_waitcnt vmcnt(0)" ::: "memory");
    } else {
      XB_SPIN(xb_ld(&bar[XB_XGEN(b.x)]) == gen, bar);
      __builtin_amdgcn_fence(__ATOMIC_ACQUIRE, "agent");
      asm volatile("s_waitcnt vmcnt(0)" ::: "memory");
    }
  }
  __syncthreads();
}

constexpr int BK = 64, HALF = 128, HT = HALF * BK;

__device__ __forceinline__ int lds_byte(int r, int c) {
  int st = (r >> 4) * 2 + (c >> 5), rr = r & 15, cc = c & 31, ob = rr * 64 + cc * 2;
  return st * 1024 + (ob ^ (((ob >> 9) & 1) << 5));
}
__device__ __forceinline__ void stage_rc(int b, int& R, int& C) {
  int st = b / 1024, sb = b % 1024, swz = sb ^ (((sb >> 9) & 1) << 5);
  R = (st >> 1) * 16 + swz / 64;
  C = (st & 1) * 32 + (swz % 64) / 2;
}

constexpr float QSC = 0.18033688011112042f;
enum { M_EVEN_IN = 0, M_OUT_F32 = 1, M_ODD_IN = 2, M_FOLD = 3, M_DFT2 = 4 };

struct Epi {
  h16* o0;
  h16* o1;
  h16* o2;
  h16* o3;
  float* f0;
  float* f1;
  const float* rope;
  int il;
  int aux;
  float scale;
};

__device__ __forceinline__ float4 cs_ld4(const float* cs, int r, int c) {
  return *reinterpret_cast<const float4*>(cs + r * 256 + (c ^ (((r >> 2) & 3) << 4)));
}
__device__ __forceinline__ float cs_ld1(const float* cs, int r, int c) { return cs[r * 256 + (c ^ (((r >> 2) & 3) << 4))]; }
__device__ __forceinline__ h16x4 cvt4(float4 v) {
  h16x4 o;
  o[0] = (h16)v.x; o[1] = (h16)v.y; o[2] = (h16)v.z; o[3] = (h16)v.w;
  return o;
}

template <int MODE>
__device__ __forceinline__ void epi_store(const int swid, const float* cs, int grow0, int bcol, const Epi& e) {
  const int tid = TIDX, wid = tid >> 6, lane = tid & 63;
  if (MODE == M_EVEN_IN && bcol >= 4352 && bcol < 6400) {
    size_t sbase;
    int T, t0;
    if (grow0 < NPR) { sbase = (size_t)(grow0 >> 8) * 524288; T = 256; t0 = grow0 & 255; }
    else { int r2 = grow0 - NPR; sbase = (size_t)16777216 + (size_t)(r2 >> 11) * 4194304; T = 2048; t0 = r2 & 2047; }
#pragma unroll 1
    for (int it = 0; it < 2; ++it) {
      const int idx = it * 512 + tid;
      const int col = idx & 255, rg = idx >> 8;
      const int np = bcol + col - 4352;
      const int csn = np >> 10, gf = np & 1023;
      h16* dst = e.o2 + sbase + ((size_t)gf * 2 + csn) * T + t0 + rg * 32;
#pragma unroll
      for (int part = 0; part < 4; ++part) {
        h16x8 o;
#pragma unroll
        for (int q = 0; q < 8; ++q) o[q] = (h16)cs_ld1(cs, rg * 32 + part * 8 + q, col);
        *reinterpret_cast<h16x8*>(dst + part * 8) = o;
      }
    }
    return;
  }
  if (MODE == M_ODD_IN && bcol < 2560) {
    const bool sample = grow0 >= NPR;
    const bool isq = bcol < 2048;
#pragma unroll 1
    for (int it = 0; it < 8; ++it) {
      const int r = it * 16 + wid * 2 + (lane >> 5);
      const int l5 = lane & 31, grp = l5 >> 2, sub = l5 & 3;
      const int c = grp * 32 + sub * 4;
      const int row = grow0 + r;
      float4 v1 = cs_ld4(cs, r, c), v2 = cs_ld4(cs, r, c + 16);
      float4 r1 = v1, r2 = v2;
      if (sample) {
        const int t = (row - NPR) & 2047;
        const int pos = (grp & 1) ? (t & 63) : (t >> 6);
        const float4 ra = *reinterpret_cast<const float4*>(e.rope + (pos * 16 + sub * 4) * 2);
        const float4 rb = *reinterpret_cast<const float4*>(e.rope + (pos * 16 + sub * 4) * 2 + 4);
        r1.x = v1.x * ra.x - v2.x * ra.y; r2.x = v2.x * ra.x + v1.x * ra.y;
        r1.y = v1.y * ra.z - v2.y * ra.w; r2.y = v2.y * ra.z + v1.y * ra.w;
        r1.z = v1.z * rb.x - v2.z * rb.y; r2.z = v2.z * rb.x + v1.z * rb.y;
        r1.w = v1.w * rb.z - v2.w * rb.w; r2.w = v2.w * rb.z + v1.w * rb.w;
      }
      if (isq) {
        r1.x *= QSC; r1.y *= QSC; r1.z *= QSC; r1.w *= QSC;
        r2.x *= QSC; r2.y *= QSC; r2.z *= QSC; r2.w *= QSC;
        h16* dst = e.o0 + (size_t)row * 2048 + bcol + c;
        *reinterpret_cast<h16x4*>(dst) = cvt4(r1);
        *reinterpret_cast<h16x4*>(dst + 16) = cvt4(r2);
      } else {
        const int cp = bcol - 2048 + c;
        h16* dst = e.o1 + (size_t)row * 512 + cp;
        *reinterpret_cast<h16x4*>(dst) = cvt4(r1);
        *reinterpret_cast<h16x4*>(dst + 16) = cvt4(r2);
        if (!sample) {
          float* fo = e.f0 + ((size_t)((row >> 8) * 2 + e.il) * 256 + (row & 255)) * 512 + cp;
          *reinterpret_cast<float4*>(fo) = v1;
          *reinterpret_cast<float4*>(fo + 16) = v2;
        }
      }
    }
    return;
  }
#pragma unroll 1
  for (int it = 0; it < 8; ++it) {
    const int r = it * 16 + wid * 2 + (lane >> 5);
    const int c = (lane & 31) * 8;
    const int row = grow0 + r, col = bcol + c;
    const float4 va = cs_ld4(cs, r, c), vb = cs_ld4(cs, r, c + 4);
    h16x8 hv;
    hv[0] = (h16)va.x; hv[1] = (h16)va.y; hv[2] = (h16)va.z; hv[3] = (h16)va.w;
    hv[4] = (h16)vb.x; hv[5] = (h16)vb.y; hv[6] = (h16)vb.z; hv[7] = (h16)vb.w;
    if (MODE == M_OUT_F32 || MODE == M_FOLD) {
      *reinterpret_cast<h16x8*>(e.o0 + (size_t)row * 2048 + col) = hv;
    } else if (MODE == M_DFT2) {
      h16* ptr = e.o0 + (size_t)row * 1024 + e.aux + col;
      const h16x8 g = *reinterpret_cast<const h16x8*>(ptr);
      const float vv[8] = {va.x, va.y, va.z, va.w, vb.x, vb.y, vb.z, vb.w};
      h16x8 o;
#pragma unroll
      for (int q = 0; q < 8; ++q) o[q] = (h16)(vv[q] * e.scale * siluf_((float)g[q]));
      *reinterpret_cast<h16x8*>(ptr) = o;
    } else if (MODE == M_EVEN_IN) {
      if (bcol < 3328) *reinterpret_cast<h16x8*>(e.o0 + (size_t)row * 3328 + col) = hv;
      else if (bcol < 4352) *reinterpret_cast<h16x8*>(e.o1 + (size_t)row * 1024 + (col - 3328)) = hv;
      else *reinterpret_cast<h16x8*>(e.o3 + (size_t)row * 1024 + (col - 6400)) = hv;
    } else if (MODE == M_ODD_IN) {
      const bool sample = grow0 >= NPR;
      if (bcol < 3072) {
        const int cp = col - 2560;
        *reinterpret_cast<h16x8*>(e.o2 + (size_t)row * 512 + cp) = hv;
        if (!sample) {
          float* fo = e.f1 + ((size_t)((row >> 8) * 2 + e.il) * 256 + (row & 255)) * 512 + cp;
          *reinterpret_cast<float4*>(fo) = va;
          *reinterpret_cast<float4*>(fo + 4) = vb;
        }
      } else {
        *reinterpret_cast<h16x8*>(e.o3 + (size_t)row * 2048 + (col - 3072)) = hv;
      }
    }
  }
}

template <int MODE>
__device__ __forceinline__ void gemm_tile(const int swid, const h16* __restrict__ A0, const h16* __restrict__ A1, int ksplit, int lda,
                                          const h16* __restrict__ Bt, int ldb, int K, int brow, int bcol, const Epi& e) {
  h16* shm = (h16*)smem;
  asm volatile("" : "+s"(K), "+s"(lda), "+s"(ldb));
#define SA(b, h) (shm + ((b) * 2 + (h)) * HT)
#define SB(b, h) (shm + (4 + (b) * 2 + (h)) * HT)
#define STAGE_A(P, br, kt)                                                                                      \
  do {                                                                                                          \
    unsigned long long _ub = (unsigned long long)((((kt) < ksplit) ? (A0 + (long)(kt) * BK) : (A1 + (long)((kt) - ksplit) * BK)) + (long)(br) * lda); \
    asm volatile("" : "+s"(_ub)); \
    __builtin_amdgcn_global_load_lds((const unsigned*)((const char*)_ub + offA0), (unsigned*)((char*)(P) + swid * 1024), 16, 0, 0); \
    __builtin_amdgcn_global_load_lds((const unsigned*)((const char*)_ub + offA1), (unsigned*)((char*)(P) + swid * 1024 + 8192), 16, 0, 0); \
  } while (0)
#define STAGE_B(P, bc, kt)                                                                                      \
  do {                                                                                                          \
    unsigned long long _ub = (unsigned long long)(Bt + (long)(kt) * BK + (long)(bc) * ldb); \
    asm volatile("" : "+s"(_ub)); \
    __builtin_amdgcn_global_load_lds((const unsigned*)((const char*)_ub + offB0), (unsigned*)((char*)(P) + swid * 1024), 16, 0, 0); \
    __builtin_amdgcn_global_load_lds((const unsigned*)((const char*)_ub + offB1), (unsigned*)((char*)(P) + swid * 1024 + 8192), 16, 0, 0); \
  } while (0)
#define LDA(dst, b, h)                                                                                          \
  for (int m = 0; m < 4; ++m)                                                                                   \
    for (int k = 0; k < 2; ++k)                                                                                 \
  dst[m][k] = *reinterpret_cast<const h16x8*>(pa_lds + (((b) * 2 + (h)) * HT * 2 + m * 2048 + k * 1024))
#define LDB(dst, b, h)                                                                                          \
  for (int n = 0; n < 2; ++n)                                                                                   \
    for (int k = 0; k < 2; ++k)                                                                                 \
  dst[n][k] = *reinterpret_cast<const h16x8*>(pb_lds + (((4 + (b) * 2 + (h)) * HT * 2) + n * 2048 + k * 1024))
#define MMA(ai, bj, At, Bq)                                                                                     \
  do {                                                                                                          \
    __builtin_amdgcn_s_setprio(1);                                                                              \
    for (int m = 0; m < 4; ++m)                                                                                 \
      for (int n = 0; n < 2; ++n)                                                                               \
        for (int k = 0; k < 2; ++k)                                                                             \
          acc[ai][bj][m][n] = __builtin_amdgcn_mfma_f32_16x16x32_f16(At[m][k], Bq[n][k], acc[ai][bj][m][n], 0, 0, 0); \
    __builtin_amdgcn_s_setprio(0);                                                                              \
  } while (0)
#define WAIT_V(n) asm volatile("s_waitcnt vmcnt(" #n ")" ::: "memory")
#define WAIT_L(n) asm volatile("s_waitcnt lgkmcnt(" #n ")" ::: "memory")
#define BAR __builtin_amdgcn_s_barrier()
#define SCHED __builtin_amdgcn_sched_barrier(0)

  const int wid = swid, lane = lane_id_(), wr = wid >> 2, wc = wid & 3, fr = lane & 15, fq = lane >> 4;
  unsigned offA0, offA1, offB0, offB1;
  {
    int r0, c0, r1, c1;
    const int tb = (swid * 64 + lane) * 16;
    stage_rc(tb, r0, c0);
    stage_rc(tb + 8192, r1, c1);
    offA0 = (unsigned)(r0 * lda + c0) * 2u; offA1 = (unsigned)(r1 * lda + c1) * 2u;
    offB0 = (unsigned)(r0 * ldb + c0) * 2u; offB1 = (unsigned)(r1 * ldb + c1) * 2u;
  }
  const char* pa_lds = (const char*)smem + lds_byte(wr * 64 + fr, fq * 8);
  const char* pb_lds = (const char*)smem + lds_byte(wc * 32 + fr, fq * 8);
  f32x4 acc[2][2][4][2] = {};
  h16x8 At[4][2], B0[2][2], B1[2][2];
  const int nt = K / BK;
  STAGE_B(SB(0, 0), bcol, 0);
  STAGE_A(SA(0, 0), brow, 0);
  STAGE_B(SB(0, 1), bcol + HALF, 0);
  STAGE_A(SA(0, 1), brow + HALF, 0);
  if (wr == 1) BAR;
  WAIT_V(4);
  BAR;
  STAGE_B(SB(1, 0), bcol, 1);
  STAGE_A(SA(1, 0), brow, 1);
  STAGE_B(SB(1, 1), bcol + HALF, 1);
  WAIT_V(6);
  BAR;
  for (int t = 0; t < nt - 2; t += 2) {
    LDB(B0, 0, 0); SCHED; LDA(At, 0, 0); STAGE_A(SA(1, 1), brow + HALF, t + 1);
    WAIT_L(8); BAR; WAIT_L(0); MMA(0, 0, At, B0); BAR; SCHED;
    LDB(B1, 0, 1); STAGE_B(SB(0, 0), bcol, t + 2);
    BAR; WAIT_L(0); MMA(0, 1, At, B1); BAR;
    LDA(At, 0, 1); STAGE_A(SA(0, 0), brow, t + 2);
    BAR; WAIT_L(0); MMA(1, 0, At, B0); BAR; SCHED;
    STAGE_B(SB(0, 1), bcol + HALF, t + 2);
    WAIT_V(6); BAR; MMA(1, 1, At, B1); BAR;
    LDB(B0, 1, 0); SCHED; LDA(At, 1, 0); STAGE_A(SA(0, 1), brow + HALF, t + 2);
    WAIT_L(8); BAR; WAIT_L(0); MMA(0, 0, At, B0); BAR; SCHED;
    LDB(B1, 1, 1); STAGE_B(SB(1, 0), bcol, t + 3);
    BAR; WAIT_L(0); MMA(0, 1, At, B1); BAR;
    LDA(At, 1, 1); STAGE_A(SA(1, 0), brow, t + 3);
    BAR; WAIT_L(0); MMA(1, 0, At, B0); BAR; SCHED;
    STAGE_B(SB(1, 1), bcol + HALF, t + 3);
    WAIT_V(6); BAR; MMA(1, 1, At, B1); BAR;
  }
  {
    LDB(B0, 0, 0); LDA(At, 0, 0); STAGE_A(SA(1, 1), brow + HALF, nt - 1);
    BAR; WAIT_L(0); MMA(0, 0, At, B0); BAR;
    LDB(B1, 0, 1); BAR; WAIT_L(0); MMA(0, 1, At, B1); BAR;
    LDA(At, 0, 1); WAIT_V(4); BAR; WAIT_L(0); MMA(1, 0, At, B0); MMA(1, 1, At, B1); BAR;
  }
  {
    LDB(B0, 1, 0); LDA(At, 1, 0); WAIT_V(2); BAR; WAIT_L(0); MMA(0, 0, At, B0); BAR;
    LDB(B1, 1, 1); WAIT_V(0); BAR; WAIT_L(0); MMA(0, 1, At, B1); BAR;
    LDA(At, 1, 1); BAR; WAIT_L(0); MMA(1, 0, At, B0); MMA(1, 1, At, B1); BAR;
  }
  if (wr == 0) BAR;

  {
    float* cs = (float*)smem;
#pragma unroll
    for (int ai = 0; ai < 2; ++ai) {
#pragma unroll
      for (int bj = 0; bj < 2; ++bj)
#pragma unroll
        for (int m = 0; m < 4; ++m)
#pragma unroll
          for (int n = 0; n < 2; ++n)
#pragma unroll
            for (int j = 0; j < 4; ++j) {
              const int r = wr * 64 + m * 16 + fq * 4 + j;
              const int c = (bj * 128 + wc * 32 + n * 16 + fr) ^ (fq << 4);
              cs[r * 256 + c] = acc[ai][bj][m][n][j];
            }
      __syncthreads();
      epi_store<MODE>(swid, cs, brow + ai * HALF, bcol, e);
      __syncthreads();
    }
  }
#undef SA
#undef SB
#undef STAGE_A
#undef STAGE_B
#undef LDA
#undef LDB
#undef MMA
}

__device__ __forceinline__ bool tile_of(int step, int nM, int nN, int& pm, int& pn) {
  const int G = gridDim.x, b = blockIdx.x;
  const int ntiles = nM * nN, chunk = ntiles >> 3, nslots = G >> 3;
  const int xcd = b & 7, slot = b >> 3;
  const int L = step * nslots + slot;
  if (L >= chunk) return false;
  const int wgid = xcd * chunk + L;
  const int WGM = 4;
  const int nig = WGM * nN, gid = wgid / nig, fm = gid * WGM, gsz = min(nM - fm, WGM);
  pm = fm + ((wgid % nig) % gsz);
  pn = (wgid % nig) / gsz;
  return true;
}

struct ConvDesc { const float* src; h16* dst; };
__device__ __forceinline__ int conv_items(int layer) { return (layer & 1) ? (80 * 32 + 1024) : (84 * 32 + 1024); }
__device__ __forceinline__ ConvDesc conv_decode(const Params& p, int layer, int it, int& ldn) {
  h16* WT = (h16*)(p.ws + OFF_WT);
  h16* WO = (h16*)(p.ws + OFF_WO);
  const int il = layer >> 1;
  ConvDesc d;
  if (layer & 1) {
    if (it < 80 * 32) {
      int nt = it >> 5, kt = it & 31;
      ldn = 5120;
      d.src = p.odd_w_in + (size_t)il * 2048 * 5120 + (size_t)(kt * 64) * 5120 + nt * 64;
      d.dst = WT + (size_t)(nt * 64) * 2048 + kt * 64;
    } else {
      it -= 80 * 32;
      int nt = it >> 5, kt = it & 31;
      ldn = 2048;
      d.src = p.odd_w_out + (size_t)il * 2048 * 2048 + (size_t)(kt * 64) * 2048 + nt * 64;
      d.dst = WO + (size_t)(nt * 64) * 2048 + kt * 64;
    }
  } else {
    if (it < 84 * 32) {
      int nt = it >> 5, kt = it & 31;
      int srccol = nt * 64, dstrow = nt * 64;
      if (nt >= 68) { srccol = 5376 + (nt - 68) * 64; dstrow = 6400 + (nt - 68) * 64; }
      ldn = 6400;
      d.src = p.even_w_in + (size_t)il * 2048 * 6400 + (size_t)(kt * 64) * 6400 + srccol;
      d.dst = WT + (size_t)dstrow * 2048 + kt * 64;
    } else {
      it -= 84 * 32;
      int nt = it >> 5, kt = it & 31;
      ldn = 2048;
      d.src = p.even_w_out + (size_t)il * 2048 * 2048 + (size_t)(kt * 64) * 2048 + nt * 64;
      d.dst = WO + (size_t)(nt * 64) * 2048 + kt * 64;
    }
  }
  return d;
}
__device__ __forceinline__ void conv_run(const Params& p, const int swid, int layer, int first, int step, int count) {
  if (first >= count) return;
  float* tile = (float*)smem;
  const int tid = TIDX;
  const int kk = tid >> 4, n4 = tid & 15, nn = tid >> 3, kc = tid & 7;
  int ldn;
  ConvDesc d = conv_decode(p, layer, first, ldn);
  float4 r0 = *reinterpret_cast<const float4*>(d.src + (size_t)kk * ldn + n4 * 4);
  float4 r1 = *reinterpret_cast<const float4*>(d.src + (size_t)(kk + 32) * ldn + n4 * 4);
#pragma unroll 1
  for (int it = first; it < count; it += step) {
    ConvDesc dn = d;
    float4 q0 = r0, q1 = r1;
    if (it + step < count) {
      int ldn2;
      dn = conv_decode(p, layer, it + step, ldn2);
      q0 = *reinterpret_cast<const float4*>(dn.src + (size_t)kk * ldn2 + n4 * 4);
      q1 = *reinterpret_cast<const float4*>(dn.src + (size_t)(kk + 32) * ldn2 + n4 * 4);
    }
    tile[kk * 65 + n4 * 4 + 0] = r0.x; tile[kk * 65 + n4 * 4 + 1] = r0.y; tile[kk * 65 + n4 * 4 + 2] = r0.z; tile[kk * 65 + n4 * 4 + 3] = r0.w;
    tile[(kk + 32) * 65 + n4 * 4 + 0] = r1.x; tile[(kk + 32) * 65 + n4 * 4 + 1] = r1.y;
    tile[(kk + 32) * 65 + n4 * 4 + 2] = r1.z; tile[(kk + 32) * 65 + n4 * 4 + 3] = r1.w;
    __syncthreads();
    h16x8 o;
#pragma unroll
    for (int q = 0; q < 8; ++q) o[q] = (h16)tile[(kc * 8 + q) * 65 + nn];
    *reinterpret_cast<h16x8*>(d.dst + (size_t)nn * 2048 + kc * 8) = o;
    __syncthreads();
    d = dn; r0 = q0; r1 = q1;
  }
}

__device__ __forceinline__ void fold_tile(const Params& p, const int swid, int il, int tix) {
  const int pn = tix & 7, g = (tix >> 3) & 3, cs = tix >> 5;
  const h16* TWC = (const h16*)(p.ws + OFF_TWC) + (size_t)cs * 65536;
  const h16* WU = (const h16*)(p.ws + OFF_WU) + (size_t)il * 2048 * 1024 + g * 256;
  Epi e{};
  e.o0 = (h16*)(p.ws + OFF_WT) + (size_t)(4352 + cs * 1024 + g * 256) * 2048;
  gemm_tile<M_FOLD>(swid, TWC, TWC, 1 << 30, 256, WU, 1024, 256, 0, pn * 256, e);
}

__device__ __forceinline__ void phase0(const Params& p, const int swid) {
  const int G = gridDim.x, b = blockIdx.x, tid = TIDX;
  const int wid = tid >> 6, lane = tid & 63;
  if (b < 384) {
    float* sc = (float*)smem;
    float* part = (float*)(p.ws + OFF_PART);
    for (int it = b; it < 384; it += G) {
      const int l = it / 96, r = it % 96, kc = r / 12, cg = r % 12;
      __syncthreads();
      for (int i = tid; i < 9 * 256; i += NTHR) {
        const int c = i >> 8, k = kc * 256 + (i & 255);
        const float v = (c == 0) ? p.c_ctx[k] : p.c[(c - 1) * 2048 + k];
        sc[i] = siluf_(v);
      }
      __syncthreads();
      const int n = cg * 512 + tid;
      const float* W = p.mod_w + ((size_t)l * 2048 + kc * 256) * 6144 + n;
      float acc[9];
#pragma unroll
      for (int c = 0; c < 9; ++c) acc[c] = 0.f;
#pragma unroll 16
      for (int k = 0; k < 256; ++k) {
        const float w = W[(size_t)k * 6144];
#pragma unroll
        for (int c = 0; c < 9; ++c) acc[c] = fmaf(w, sc[c * 256 + k], acc[c]);
      }
      const float bias0 = (kc == 0) ? p.mod_b[(size_t)l * 6144 + n] : 0.f;
#pragma unroll
      for (int c = 0; c < 9; ++c) part[((size_t)(l * 8 + kc) * 9 + c) * 6144 + n] = acc[c] + bias0;
    }
    __syncthreads();
  }
  const int n_conv = conv_items(0);
  const int I_WU = n_conv, I_TWC = I_WU + 1024, I_TW2048 = I_TWC + 32, I_TW256 = I_TW2048 + 2048, I_ROPE = I_TW256 + 32,
            I_LW = I_ROPE + 1, I_CC = I_LW + 128, I_END = I_CC + 1024;
  conv_run(p, swid, 0, b, G, n_conv);
  for (int it = b; it < I_END; it += G) {
    if (it < n_conv) {
      continue;
    } else if (it < I_TWC) {
      int base = (it - I_WU) * 4096 + tid * 8;
      int il = base >> 21, rem = base & ((1 << 21) - 1), k = rem >> 10, c = rem & 1023;
      const float* s = p.even_w_in + ((size_t)il * 2048 + k) * 6400 + 4352 + c;
      float4 a = *reinterpret_cast<const float4*>(s), bb = *reinterpret_cast<const float4*>(s + 4);
      h16x8 o;
      o[0] = (h16)a.x; o[1] = (h16)a.y; o[2] = (h16)a.z; o[3] = (h16)a.w;
      o[4] = (h16)bb.x; o[5] = (h16)bb.y; o[6] = (h16)bb.z; o[7] = (h16)bb.w;
      *reinterpret_cast<h16x8*>((h16*)(p.ws + OFF_WU) + base) = o;
    } else if (it < I_TW2048) {
      int base = (it - I_TWC) * 4096 + tid * 8;
      int cs = base >> 16, f = (base >> 8) & 255, c0 = base & 255;
      h16x8 o;
#pragma unroll
      for (int q = 0; q < 8; ++q) {
        float x = (float)((f * (c0 + q)) & 255) * (1.f / 256.f);
        o[q] = (h16)(cs ? __builtin_amdgcn_sinf(x) : __builtin_amdgcn_cosf(x));
      }
      *reinterpret_cast<h16x8*>((h16*)(p.ws + OFF_TWC) + base) = o;
    } else if (it < I_TW256) {
      int base = (it - I_TW2048) * 4096 + tid * 8;
      int f = base >> 12, k0 = base & 4095;
      h16x8 o;
#pragma unroll
      for (int q = 0; q < 8; ++q) {
        int k = k0 + q;
        int sn = k >> 11, t = k & 2047;
        float x = (float)((f * t) & 2047) * (1.f / 2048.f);
        o[q] = (h16)(sn ? -__builtin_amdgcn_sinf(x) : __builtin_amdgcn_cosf(x));
      }
      *reinterpret_cast<h16x8*>((h16*)(p.ws + OFF_TW2048) + base) = o;
    } else if (it < I_ROPE) {
      int base = (it - I_TW256) * 4096 + tid * 8;
      int f = base >> 9, k0 = base & 511;
      h16x8 o;
#pragma unroll
      for (int q = 0; q < 8; ++q) {
        int k = k0 + q;
        int sn = k >> 8, t = k & 255;
        float x = (float)((f * t) & 255) * (1.f / 256.f);
        o[q] = (h16)(sn ? -__builtin_amdgcn_sinf(x) : __builtin_amdgcn_cosf(x));
      }
      *reinterpret_cast<h16x8*>((h16*)(p.ws + OFF_TW256) + base) = o;
    } else if (it < I_LW) {
      for (int i = tid; i < 1024; i += NTHR) {
        int pos = i >> 4, fi = i & 15;
        float inv = 1.0f / exp2f((float)fi * (13.287712379549449f / 16.f));
        float ang = (float)pos * inv;
        float x = ang * 0.15915494309189535f;
        x = x - floorf(x);
        ((float*)(p.ws + OFF_ROPE))[i * 2] = __builtin_amdgcn_cosf(x);
        ((float*)(p.ws + OFF_ROPE))[i * 2 + 1] = __builtin_amdgcn_sinf(x);
      }
    } else if (it >= I_CC) {
      int base = (it - I_CC) * 4096 + tid * 8;
      int which = base >= (int)CACHE_ELEMS;
      int off = base - which * (int)CACHE_ELEMS;
      const float* src = (which ? p.cache_v : p.cache_k) + off;
      float4 a = *reinterpret_cast<const float4*>(src), bb = *reinterpret_cast<const float4*>(src + 4);
      h16x8 o;
      o[0] = (h16)a.x; o[1] = (h16)a.y; o[2] = (h16)a.z; o[3] = (h16)a.w;
      o[4] = (h16)bb.x; o[5] = (h16)bb.y; o[6] = (h16)bb.z; o[7] = (h16)bb.w;
      *reinterpret_cast<h16x8*>((h16*)(p.ws + (which ? OFF_CV : OFF_CK)) + off) = o;
    } else {
      int ti = (it - I_LW) * 512 + tid;
      int kc = ti & 7, n = (ti >> 3) & 1023, combo = ti >> 13;
      int il = combo >> 2, type = (combo >> 1) & 1, dir = combo & 1;
      const float* src = (type ? p.even_a_up : p.even_w_up) + ((size_t)(il * 2 + dir) * 64 + kc * 8) * 1024 + n;
      h16x8 o;
#pragma unroll
      for (int q = 0; q < 8; ++q) o[q] = (h16)src[(size_t)q * 1024];
      *reinterpret_cast<h16x8*>((h16*)(p.ws + OFF_LW) + ((size_t)combo * 1024 + n) * 64 + kc * 8) = o;
    }
  }
}

__device__ __forceinline__ void norm_rows(const Params& p, const int swid, int l_done, int l_next) {
  const int tid = TIDX, wid = tid >> 6, lane = tid & 63;
  const float* mod = (const float*)(p.ws + OFF_PART);
  const h16* yout = (const h16*)(p.ws + OFF_C);
  h16* H = (h16*)(p.ws + OFF_H);
  const bool has_y = l_done >= 0, has_h = l_next < 4;
  float* par = (float*)smem;
  const int brow0 = blockIdx.x * 96;
  auto cond_of = [&](int row) -> int { return (row < NPR) ? 0 : 1 + ((row - NPR) >> 11); };
  const int c_first = cond_of(brow0), c_last = cond_of(brow0 + 95);
  __syncthreads();
  const int nset = (c_last != c_first) ? 2 : 1;
  for (int i = tid; i < nset * 2048; i += NTHR) {
    const int set = i >> 11, col = i & 2047;
    const int c = set ? c_last : c_first;
    float v1 = 0.f, v2 = 0.f, v3 = 0.f;
    auto mod_get = [&](int l, int idx) -> float {
      float sum = 0.f;
#pragma unroll
      for (int kc = 0; kc < 8; ++kc) sum += mod[((size_t)(l * 8 + kc) * 9 + c) * 6144 + idx];
      return sum;
    };
    if (has_y) v1 = mod_get(l_done, 4096 + col) * p.norm_post[(size_t)l_done * 2048 + col];
    if (has_h) {
      v2 = p.norm_pre[(size_t)l_next * 2048 + col] * (1.f + mod_get(l_next, 2048 + col));
      v3 = mod_get(l_next, col);
    }
    par[(set * 3 + 0) * 2048 + col] = v1;
    par[(set * 3 + 1) * 2048 + col] = v2;
    par[(set * 3 + 2) * 2048 + col] = v3;
  }
  __syncthreads();
  const int rbase = brow0 + wid * 12;
  auto row_ptr = [&](int row) -> const float* {
    if (l_done <= 0) return (row < NPR) ? (p.x_prompt + (size_t)row * 2048) : (p.x_sample + (size_t)(row - NPR) * 2048);
    return p.out + (size_t)row * 2048;
  };
  struct RowBuf { float4 x[8]; h16x4 y[8]; };
  auto load_row = [&](int row, RowBuf& rb) {
    const float* xin = row_ptr(row);
#pragma unroll
    for (int i = 0; i < 8; ++i) rb.x[i] = *reinterpret_cast<const float4*>(xin + i * 256 + lane * 4);
    if (has_y) {
#pragma unroll
      for (int i = 0; i < 8; ++i) rb.y[i] = *reinterpret_cast<const h16x4*>(yout + (size_t)row * 2048 + i * 256 + lane * 4);
    }
  };
  auto process = [&](int row, RowBuf& rb) {
    const float* ps = par + ((cond_of(row) == c_first) ? 0 : 3 * 2048) + lane * 4;
    if (has_y) {
      float ss = 0.f;
#pragma unroll
      for (int i = 0; i < 8; ++i)
#pragma unroll
        for (int e = 0; e < 4; ++e) { const float yv = (float)rb.y[i][e]; ss += yv * yv; }
      ss = wave_sum(ss);
      const float rstd = rsqrtf(ss * (1.f / 2048.f) + 1e-6f);
#pragma unroll
      for (int i = 0; i < 8; ++i) {
        const float4 q1 = *reinterpret_cast<const float4*>(ps + i * 256);
        rb.x[i].x += q1.x * ((float)rb.y[i][0] * rstd);
        rb.x[i].y += q1.y * ((float)rb.y[i][1] * rstd);
        rb.x[i].z += q1.z * ((float)rb.y[i][2] * rstd);
        rb.x[i].w += q1.w * ((float)rb.y[i][3] * rstd);
        *reinterpret_cast<float4*>(p.out + (size_t)row * 2048 + i * 256 + lane * 4) = rb.x[i];
      }
    }
    if (has_h) {
      float ss = 0.f;
#pragma unroll
      for (int i = 0; i < 8; ++i) ss += rb.x[i].x * rb.x[i].x + rb.x[i].y * rb.x[i].y + rb.x[i].z * rb.x[i].z + rb.x[i].w * rb.x[i].w;
      ss = wave_sum(ss);
      const float rstd = rsqrtf(ss * (1.f / 2048.f) + 1e-6f);
#pragma unroll
      for (int i = 0; i < 8; ++i) {
        const float4 q2 = *reinterpret_cast<const float4*>(ps + 2048 + i * 256);
        const float4 q3 = *reinterpret_cast<const float4*>(ps + 4096 + i * 256);
        h16x4 o;
        o[0] = (h16)(rb.x[i].x * rstd * q2.x + q3.x);
        o[1] = (h16)(rb.x[i].y * rstd * q2.y + q3.y);
        o[2] = (h16)(rb.x[i].z * rstd * q2.z + q3.z);
        o[3] = (h16)(rb.x[i].w * rstd * q2.w + q3.w);
        *reinterpret_cast<h16x4*>(H + (size_t)row * 2048 + i * 256 + lane * 4) = o;
      }
    }
  };
  RowBuf A, B;
  load_row(rbase, A);
#pragma unroll 1
  for (int k = 0; k < 12; k += 2) {
    load_row(rbase + k + 1, B);
    process(rbase + k, A);
    if (k + 2 < 12) load_row(rbase + k + 2, A);
    process(rbase + k + 1, B);
  }
  __syncthreads();
}

__device__ __forceinline__ void even_prep(const Params& p, const int swid, int il) {
  const int tid = TIDX, wid = tid >> 6, lane = tid & 63;
  const h16* PA = (const h16*)(p.ws + OFF_PA);
  h16* RS = (h16*)(p.ws + OFF_H);
  h16* KS = RS + NT1K;
  h16* Cb = (h16*)(p.ws + OFF_C);
  h16* VS = Cb + 4 * NT1K;
  float* RN = (float*)(p.ws + OFF_RN);
  const float* mu = p.even_mu + (size_t)il * 3328;
  const float* kkw = p.even_k_k + (size_t)il * 1024;
  h16* Alow = (h16*)smem;
  const int LDL = 264;
  const h16* LW = (const h16*)(p.ws + OFF_LW) + (size_t)il * 4 * 1024 * 64;
  for (int item = blockIdx.x; item < NT / 32; item += gridDim.x) {
    const int row0 = item * 32;
    {
      const int rbase = row0 + wid * 4;
      int T, t0;
      if (rbase < NPR) { T = 256; t0 = rbase & 255; } else { T = 2048; t0 = (rbase - NPR) & 2047; }
      const bool has_m1 = t0 > 0, has_p4 = (t0 + 4) < T;
      const h16* base = PA + (size_t)rbase * 3328;
      struct RowsIn { h16x8 x[6]; float4 m0, m1, k0, k1; };
      auto load_rows = [&](int ch, RowsIn& in) {
        const int c0 = ch * 8;
        in.x[0] = h16x8{}; in.x[5] = h16x8{};
        if (has_m1) in.x[0] = *reinterpret_cast<const h16x8*>(base - 3328 + c0);
#pragma unroll
        for (int i = 0; i < 4; ++i) in.x[i + 1] = *reinterpret_cast<const h16x8*>(base + (size_t)i * 3328 + c0);
        if (has_p4) in.x[5] = *reinterpret_cast<const h16x8*>(base + (size_t)4 * 3328 + c0);
        in.m0 = *reinterpret_cast<const float4*>(mu + c0);
        in.m1 = *reinterpret_cast<const float4*>(mu + c0 + 4);
        in.k0 = float4{0.f, 0.f, 0.f, 0.f}; in.k1 = in.k0;
        if (c0 >= 1024 && c0 < 2048) {
          in.k0 = *reinterpret_cast<const float4*>(kkw + c0 - 1024);
          in.k1 = *reinterpret_cast<const float4*>(kkw + c0 - 1020);
        }
      };
      auto compute = [&](int ch, const RowsIn& in) {
        const int c0 = ch * 8;
        const float mm[8] = {in.m0.x, in.m0.y, in.m0.z, in.m0.w, in.m1.x, in.m1.y, in.m1.z, in.m1.w};
        const float kq[8] = {in.k0.x, in.k0.y, in.k0.z, in.k0.w, in.k1.x, in.k1.y, in.k1.z, in.k1.w};
#pragma unroll
        for (int tt = 0; tt < 4; ++tt) {
          const int row = rbase + tt;
          float sv[8];
#pragma unroll
          for (int q = 0; q < 8; ++q) {
            float xcq = (float)in.x[tt + 1][q];
            sv[q] = xcq + mm[q] * (0.5f * ((float)in.x[tt][q] + (float)in.x[tt + 2][q]) - xcq);
          }
          if (c0 < 3072) {
            h16x8 o;
#pragma unroll
            for (int q = 0; q < 8; ++q) o[q] = (h16)sv[q];
            if (c0 < 1024) *reinterpret_cast<h16x8*>(RS + (size_t)row * 1024 + c0) = o;
            else if (c0 < 2048) {
              *reinterpret_cast<h16x8*>(KS + (size_t)row * 1024 + (c0 - 1024)) = o;
              float ssq = 0.f;
#pragma unroll
              for (int q = 0; q < 8; ++q) { float v = (float)o[q] * kq[q]; ssq += v * v; }
              ssq += __shfl_xor(ssq, 1);
              ssq += __shfl_xor(ssq, 2);
              ssq += __shfl_xor(ssq, 4);
              if ((lane & 7) == 0) RN[(size_t)row * 16 + ((c0 - 1024) >> 6)] = 1.f / fmaxf(sqrtf(ssq), 1e-12f);
            } else *reinterpret_cast<h16x8*>(VS + (size_t)row * 1024 + (c0 - 2048)) = o;
          } else {
            const int lc = c0 - 3072;
            h16x8 o;
#pragma unroll
            for (int q = 0; q < 8; ++q) o[q] = (h16)((lc < 128) ? tanhf(sv[q]) : sv[q]);
            *reinterpret_cast<h16x8*>(Alow + (wid * 4 + tt) * LDL + lc) = o;
          }
        }
      };
      RowsIn ra, rb;
      load_rows(lane, ra);
#pragma unroll 1
      for (int i = 0; i < 6; i += 2) {
        load_rows(lane + 64 * (i + 1), rb);
        compute(lane + 64 * i, ra);
        if (i + 2 < 6 || lane < 32) load_rows(lane + 64 * (i + 2), ra);
        compute(lane + 64 * (i + 1), rb);
      }
      if (lane < 32) compute(lane + 64 * 6, ra);
    }
    __syncthreads();
    {
      const int fr = lane & 15, fq = lane >> 4;
#pragma unroll 1
      for (int combo = 0; combo < 4; ++combo) {
        const int type = combo >> 1, dir = combo & 1;
        h16x8 af[2][2];
#pragma unroll
        for (int m = 0; m < 2; ++m)
#pragma unroll
          for (int ks = 0; ks < 2; ++ks)
            af[m][ks] = *reinterpret_cast<const h16x8*>(Alow + (m * 16 + fr) * LDL + type * 128 + dir * 64 + ks * 32 + fq * 8);
        const float* bias = (type ? p.even_a0 : p.even_w0) + (size_t)(il * 2 + dir) * 1024;
        h16* dst = Cb + (size_t)(type * 2 + dir) * NT1K;
#pragma unroll 1
        for (int nti = 0; nti < 8; ++nti) {
          const int n0 = (wid * 8 + nti) * 16;
          const h16* lw = LW + ((size_t)combo * 1024 + n0 + fr) * 64 + fq * 8;
          h16x8 b0 = *reinterpret_cast<const h16x8*>(lw), b1 = *reinterpret_cast<const h16x8*>(lw + 32);
          const float bs = bias[n0 + fr];
#pragma unroll
          for (int m = 0; m < 2; ++m) {
            f32x4 acc = {0.f, 0.f, 0.f, 0.f};
            acc = __builtin_amdgcn_mfma_f32_16x16x32_f16(af[m][0], b0, acc, 0, 0, 0);
            acc = __builtin_amdgcn_mfma_f32_16x16x32_f16(af[m][1], b1, acc, 0, 0, 0);
#pragma unroll
            for (int j = 0; j < 4; ++j) {
              float v = acc[j] + bs;
              float o = type ? sigmoidf_(v) : __expf(-0.6065306597126334f * sigmoidf_(v));
              dst[(size_t)(row0 + m * 16 + fq * 4 + j) * 1024 + n0 + fr] = (h16)o;
            }
          }
        }
      }
    }
    __syncthreads();
  }
}

template <int CTRL>
__device__ __forceinline__ float dpp_f(float v) {
  return __builtin_bit_cast(float, __builtin_amdgcn_update_dpp(0, __builtin_bit_cast(int, v), CTRL, 0xF, 0xF, true));
}
__device__ __forceinline__ float red8(float v) {
  v += dpp_f<0xB1>(v);
  v += dpp_f<0x4E>(v);
  v += dpp_f<0x141>(v);
  return v;
}
__device__ __forceinline__ void red8x2(float& a, float& b) {
  asm volatile(
      "s_nop 1\n\t"
      "v_add_f32_dpp %0, %0, %0 quad_perm:[1,0,3,2] row_mask:0xf bank_mask:0xf\n\t"
      "v_add_f32_dpp %1, %1, %1 quad_perm:[1,0,3,2] row_mask:0xf bank_mask:0xf\n\t"
      "s_nop 0\n\t"
      "v_add_f32_dpp %0, %0, %0 quad_perm:[2,3,0,1] row_mask:0xf bank_mask:0xf\n\t"
      "v_add_f32_dpp %1, %1, %1 quad_perm:[2,3,0,1] row_mask:0xf bank_mask:0xf\n\t"
      "s_nop 0\n\t"
      "v_add_f32_dpp %0, %0, %0 row_half_mirror row_mask:0xf bank_mask:0xf\n\t"
      "v_add_f32_dpp %1, %1, %1 row_half_mirror row_mask:0xf bank_mask:0xf\n\t"
      : "+v"(a), "+v"(b));
}

typedef __attribute__((ext_vector_type(2))) _Float16 h16x2;
constexpr int CS = 16;
constexpr int SC_RAW = 5 * CS * 128 + 256;
constexpr int SC_F32 = 6 * CS * 256;
constexpr int SC_TEAM = 2 * SC_RAW + 2 * SC_F32;

__device__ __forceinline__ void even_scan(const Params& p, const int swid, int il) {
  const int lane = lane_id_(), wid = swid;
  const int team = wid >> 2, part = wid & 3;
  const int bi = lane >> 3, bj = lane & 7;
  const int blk = blockIdx.x;
  const h16* RS = (const h16*)(p.ws + OFF_H);
  const h16* Cb = (const h16*)(p.ws + OFF_C);
  const float* RN = (const float*)(p.ws + OFF_RN);
  h16* Ob = (h16*)(p.ws + OFF_PA);
  char* traw = smem + team * SC_TEAM;
  char* tf32 = traw + 2 * SC_RAW;
  const int i0 = part * 16 + bi * 2, j0 = bj * 8;
  const int NIT = 2048 / CS;

  auto unit_of = [&](int it, int& T, int& rowbase, int& bidx, int& h, int& dir, int& chunk) -> bool {
    int unit;
    if (it >= NIT) return false;
    if (team == 0) { unit = blk; T = 2048; chunk = it; }
    else { if (it >= 4 * (256 / CS)) return false; unit = blk * 4 + it / (256 / CS); T = 256; chunk = it % (256 / CS); }
    dir = unit & 1; h = (unit >> 1) & 15; bidx = unit >> 5;
    rowbase = (team == 0) ? (NPR + bidx * 2048) : (bidx * 256);
    return true;
  };
  auto issue_chunk = [&](int it) {
    int T, rowbase, bidx, h, dir, chunk;
    if (!unit_of(it, T, rowbase, bidx, h, dir, chunk)) return;
    char* buf = traw + (it & 1) * SC_RAW;
    const int row0 = rowbase + (dir ? (T - CS - chunk * CS) : (chunk * CS));
#pragma unroll
    for (int m = 0; m < 3; ++m) {
      const int idx = part + 4 * m;
      if (idx < 5 * (CS / 8)) {
        const int arr = idx / (CS / 8), half = idx % (CS / 8);
        const h16* base = (arr == 0) ? RS : (arr == 1) ? (RS + NT1K) : (arr == 2) ? (Cb + (size_t)dir * NT1K)
                          : (arr == 3) ? (Cb + (size_t)(2 + dir) * NT1K) : (Cb + 4 * NT1K);
        const h16* src = base + (size_t)(row0 + half * 8 + (lane >> 3)) * 1024 + h * 64 + (lane & 7) * 8;
        __builtin_amdgcn_global_load_lds((const unsigned*)src, (unsigned*)(buf + arr * (CS * 128) + half * 1024), 16, 0, 0);
      } else if (idx == 5 * (CS / 8)) {
        const int r = lane < CS ? lane : CS - 1;
        const float* src = RN + (size_t)(row0 + r) * 16 + h;
        __builtin_amdgcn_global_load_lds((const unsigned*)src, (unsigned*)(buf + 5 * CS * 128), 4, 0, 0);
      }
    }
  };
  float kkc0 = 0.f, kkc1 = 0.f, kac0 = 0.f, kac1 = 0.f;
  auto prep_chunk = [&](int it) {
    int T, rowbase, bidx, h, dir, chunk;
    if (!unit_of(it, T, rowbase, bidx, h, dir, chunk)) return;
    const int sp = lane >> 5, cp = lane & 31;
    if (chunk == 0) {
      const float2 a = *reinterpret_cast<const float2*>(p.even_k_k + (size_t)il * 1024 + h * 64 + cp * 2);
      const float2 c = *reinterpret_cast<const float2*>(p.even_k_a + (size_t)il * 1024 + h * 64 + cp * 2);
      kkc0 = a.x; kkc1 = a.y; kac0 = c.x; kac1 = c.y;
      asm volatile("s_waitcnt vmcnt(0)" ::: "memory");
      asm volatile("" : "+v"(kkc0), "+v"(kkc1), "+v"(kac0), "+v"(kac1));
    }
    const char* raw = traw + (it & 1) * SC_RAW;
    char* f = tf32 + (it & 1) * SC_F32;
#pragma unroll
    for (int pass = 0; pass < CS / 8; ++pass) {
      const int s = (CS / 4) * part + 2 * pass + sp;
      const int r = dir ? (CS - 1 - s) : s;
      const h16x2 r2 = *reinterpret_cast<const h16x2*>(raw + r * 128 + cp * 4);
      const h16x2 k2 = *reinterpret_cast<const h16x2*>(raw + CS * 128 + r * 128 + cp * 4);
      const h16x2 w2 = *reinterpret_cast<const h16x2*>(raw + 2 * CS * 128 + r * 128 + cp * 4);
      const h16x2 a2 = *reinterpret_cast<const h16x2*>(raw + 3 * CS * 128 + r * 128 + cp * 4);
      const h16x2 v2 = *reinterpret_cast<const h16x2*>(raw + 4 * CS * 128 + r * 128 + cp * 4);
      const float rn = *reinterpret_cast<const float*>(raw + 5 * CS * 128 + r * 4);
      const float kf0 = (float)k2[0], kf1 = (float)k2[1], af0 = (float)a2[0], af1 = (float)a2[1];
      float2 kk, kka, kd, rr, ww, vv;
      kk.x = kf0 * (kkc0 * rn); kk.y = kf1 * (kkc1 * rn);
      kka.x = kk.x * af0; kka.y = kk.y * af1;
      kd.x = kf0 * fmaf(af0 - 1.f, kac0, 1.f); kd.y = kf1 * fmaf(af1 - 1.f, kac1, 1.f);
      rr.x = (float)r2[0]; rr.y = (float)r2[1];
      ww.x = (float)w2[0]; ww.y = (float)w2[1];
      vv.x = (float)v2[0]; vv.y = (float)v2[1];
      char* fo = f + s * 256 + cp * 8;
      *reinterpret_cast<float2*>(fo) = kk;
      *reinterpret_cast<float2*>(fo + CS * 256) = kka;
      *reinterpret_cast<float2*>(fo + 2 * CS * 256) = kd;
      *reinterpret_cast<float2*>(fo + 3 * CS * 256) = rr;
      *reinterpret_cast<float2*>(fo + 4 * CS * 256) = ww;
      *reinterpret_cast<float2*>(fo + 5 * CS * 256) = vv;
    }
  };

  f32x2 S2[2][4];
#pragma unroll
  for (int q = 0; q < 4; ++q) { S2[0][q] = f32x2{0.f, 0.f}; S2[1][q] = f32x2{0.f, 0.f}; }
  char* tob = smem + 2 * SC_TEAM + team * (2 * CS * 128);
  auto store_o = [&](int pit) {
    int T, rowbase, bidx, h, dir, chunk;
    if (pit < 0 || part >= CS / 8) return;
    if (!unit_of(pit, T, rowbase, bidx, h, dir, chunk)) return;
    const int row0 = rowbase + (dir ? (T - CS - chunk * CS) : (chunk * CS));
    const int r = part * 8 + (lane >> 3), pc = lane & 7;
    const h16x8 v = *reinterpret_cast<const h16x8*>(tob + ((pit & 1) * CS + r) * 128 + pc * 16);
    *reinterpret_cast<h16x8*>(Ob + (size_t)dir * NT1K + (size_t)(row0 + r) * 1024 + h * 64 + pc * 8) = v;
  };

  issue_chunk(0);
  issue_chunk(1);
  asm volatile("s_waitcnt vmcnt(0)" ::: "memory");
  __syncthreads();
  prep_chunk(0);
  __syncthreads();
#pragma unroll 1
  for (int it = 0; it < NIT; ++it) {
    store_o(it - 1);
    issue_chunk(it + 2);
    prep_chunk(it + 1);
    int T, rowbase, bidx, h, dir, chunk;
    if (unit_of(it, T, rowbase, bidx, h, dir, chunk)) {
      const int ci = h * 64 + i0;
      if (chunk == 0) {
        if (team == 0) {
          const float* st = p.state_wkv + ((((size_t)bidx * 2 + il) * 2 + dir) * 16 + h) * 4096;
#pragma unroll
          for (int a2 = 0; a2 < 2; ++a2) {
            float4 s0 = *reinterpret_cast<const float4*>(st + (size_t)(i0 + a2) * 64 + j0);
            float4 s1 = *reinterpret_cast<const float4*>(st + (size_t)(i0 + a2) * 64 + j0 + 4);
            S2[a2][0] = f32x2{s0.x, s0.y}; S2[a2][1] = f32x2{s0.z, s0.w};
            S2[a2][2] = f32x2{s1.x, s1.y}; S2[a2][3] = f32x2{s1.z, s1.w};
          }
          asm volatile("s_waitcnt vmcnt(0)" ::: "memory");
#pragma unroll
          for (int q = 0; q < 4; ++q) asm volatile("" : "+v"(S2[0][q]), "+v"(S2[1][q]));
        } else {
#pragma unroll
          for (int q = 0; q < 4; ++q) { S2[0][q] = f32x2{0.f, 0.f}; S2[1][q] = f32x2{0.f, 0.f}; }
        }
      }
      const char* f = tf32 + (it & 1) * SC_F32 + j0 * 4;
      const char* fv = tf32 + (it & 1) * SC_F32 + 5 * CS * 256 + i0 * 4;
      const int row0 = rowbase + (dir ? (T - CS - chunk * CS) : (chunk * CS));
      h16* Od = Ob + (size_t)dir * NT1K + (size_t)row0 * 1024 + ci;
      const int rstart = dir ? CS - 1 : 0, rstep = dir ? -1 : 1;
      struct FIn { float4 q[10]; float2 v; };
      auto ldstep = [&](int s) -> FIn {
        FIn in;
        const float4* q0 = reinterpret_cast<const float4*>(f + s * 256);
        constexpr int VS16 = CS * 16;
        in.q[0] = q0[0]; in.q[1] = q0[1]; in.q[2] = q0[VS16]; in.q[3] = q0[VS16 + 1]; in.q[4] = q0[2 * VS16]; in.q[5] = q0[2 * VS16 + 1];
        in.q[6] = q0[3 * VS16]; in.q[7] = q0[3 * VS16 + 1]; in.q[8] = q0[4 * VS16]; in.q[9] = q0[4 * VS16 + 1];
        in.v = *reinterpret_cast<const float2*>(fv + s * 256);
        return in;
      };
      FIn cur = ldstep(0);
#pragma unroll
      for (int s = 0; s < CS; ++s) {
        FIn nxt = ldstep(s < CS - 1 ? s + 1 : CS - 1);
        f32x2 kk[4], kka[4], kd[4], rv[4], wv[4];
#pragma unroll
        for (int h2 = 0; h2 < 2; ++h2) {
          float4 t;
          t = cur.q[0 + h2]; kk[2 * h2] = f32x2{t.x, t.y}; kk[2 * h2 + 1] = f32x2{t.z, t.w};
          t = cur.q[2 + h2]; kka[2 * h2] = f32x2{t.x, t.y}; kka[2 * h2 + 1] = f32x2{t.z, t.w};
          t = cur.q[4 + h2]; kd[2 * h2] = f32x2{t.x, t.y}; kd[2 * h2 + 1] = f32x2{t.z, t.w};
          t = cur.q[6 + h2]; rv[2 * h2] = f32x2{t.x, t.y}; rv[2 * h2 + 1] = f32x2{t.z, t.w};
          t = cur.q[8 + h2]; wv[2 * h2] = f32x2{t.x, t.y}; wv[2 * h2 + 1] = f32x2{t.z, t.w};
        }
        const float2 vin = cur.v;
        float sa[2];
#pragma unroll
        for (int a2 = 0; a2 < 2; ++a2) {
          f32x2 t = S2[a2][0] * kk[0];
          t += S2[a2][1] * kk[1];
          t += S2[a2][2] * kk[2];
          t += S2[a2][3] * kk[3];
          sa[a2] = t[0] + t[1];
        }
        red8x2(sa[0], sa[1]);
        float o[2];
#pragma unroll
        for (int a2 = 0; a2 < 2; ++a2) {
          const float va = a2 ? vin.y : vin.x;
          const float nsa = -sa[a2];
          f32x2 t;
#pragma unroll
          for (int q = 0; q < 4; ++q) {
            f32x2 u = kd[q] * va + kka[q] * nsa;
            S2[a2][q] = S2[a2][q] * wv[q] + u;
            if (q == 0) t = S2[a2][q] * rv[q]; else t += S2[a2][q] * rv[q];
          }
          o[a2] = t[0] + t[1];
        }
        red8x2(o[0], o[1]);
        {
          h16x2 ov;
          ov[0] = (h16)o[0]; ov[1] = (h16)o[1];
          *reinterpret_cast<h16x2*>(tob + ((it & 1) * CS + rstart + rstep * s) * 128 + i0 * 2) = ov;
        }
        cur = nxt;
      }
      if (team == 1 && chunk == 256 / CS - 1) {
        float* so = p.out + OUT_STATE + ((((size_t)bidx * 2 + il) * 2 + dir) * 16 + h) * 4096;
#pragma unroll
        for (int a2 = 0; a2 < 2; ++a2) {
          float4 s0 = {S2[a2][0][0], S2[a2][0][1], S2[a2][1][0], S2[a2][1][1]};
          float4 s1 = {S2[a2][2][0], S2[a2][2][1], S2[a2][3][0], S2[a2][3][1]};
          *reinterpret_cast<float4*>(so + (size_t)(i0 + a2) * 64 + j0) = s0;
          *reinterpret_cast<float4*>(so + (size_t)(i0 + a2) * 64 + j0 + 4) = s1;
        }
      }
    }
    asm volatile("s_waitcnt vmcnt(0) lgkmcnt(0)" ::: "memory");
    __builtin_amdgcn_s_barrier();
    asm volatile("" ::: "memory");
  }
  store_o(NIT - 1);
}

__device__ __forceinline__ void even_post(const Params& p, const int swid, int il) {
  const int tid = TIDX, wid = tid >> 6, lane = tid & 63;
  const h16* RS = (const h16*)(p.ws + OFF_H);
  const h16* KS = RS + NT1K;
  const h16* Cb = (const h16*)(p.ws + OFF_C);
  const h16* AF = Cb + 2 * NT1K;
  const h16* AB = Cb + 3 * NT1K;
  const h16* VS = Cb + 4 * NT1K;
  const h16* OF = (const h16*)(p.ws + OFF_PA);
  const h16* OB = OF + NT1K;
  h16* GA = (h16*)(p.ws + OFF_PB);
  const int c0 = (lane >> 2) * 64 + (lane & 3) * 16;
  float ka[16], rk[16], gw[16], gb[16];
#pragma unroll
  for (int q = 0; q < 4; ++q) {
    float4 t;
    t = *reinterpret_cast<const float4*>(p.even_k_a + (size_t)il * 1024 + c0 + q * 4); ka[q * 4] = t.x; ka[q * 4 + 1] = t.y; ka[q * 4 + 2] = t.z; ka[q * 4 + 3] = t.w;
    t = *reinterpret_cast<const float4*>(p.even_r_k + (size_t)il * 1024 + c0 + q * 4); rk[q * 4] = t.x; rk[q * 4 + 1] = t.y; rk[q * 4 + 2] = t.z; rk[q * 4 + 3] = t.w;
    t = *reinterpret_cast<const float4*>(p.even_gn_w + (size_t)il * 1024 + c0 + q * 4); gw[q * 4] = t.x; gw[q * 4 + 1] = t.y; gw[q * 4 + 2] = t.z; gw[q * 4 + 3] = t.w;
    t = *reinterpret_cast<const float4*>(p.even_gn_b + (size_t)il * 1024 + c0 + q * 4); gb[q * 4] = t.x; gb[q * 4 + 1] = t.y; gb[q * 4 + 2] = t.z; gb[q * 4 + 3] = t.w;
  }
#pragma unroll 1
  for (int row = blockIdx.x * 8 + wid; row < NT; row += gridDim.x * 8) {
    const size_t idx = (size_t)row * 1024 + c0;
    h16x8 of[2], ob[2], rs[2], ks[2], vs[2], af[2], ab[2], ga[2];
#pragma unroll
    for (int hh = 0; hh < 2; ++hh) {
      of[hh] = *reinterpret_cast<const h16x8*>(OF + idx + hh * 8);
      ob[hh] = *reinterpret_cast<const h16x8*>(OB + idx + hh * 8);
      rs[hh] = *reinterpret_cast<const h16x8*>(RS + idx + hh * 8);
      ks[hh] = *reinterpret_cast<const h16x8*>(KS + idx + hh * 8);
      vs[hh] = *reinterpret_cast<const h16x8*>(VS + idx + hh * 8);
      af[hh] = *reinterpret_cast<const h16x8*>(AF + idx + hh * 8);
      ab[hh] = *reinterpret_cast<const h16x8*>(AB + idx + hh * 8);
      ga[hh] = *reinterpret_cast<const h16x8*>(GA + idx + hh * 8);
    }
    float o[16];
    float s1 = 0.f, bon = 0.f;
#pragma unroll
    for (int q = 0; q < 16; ++q) {
      const int hh = q >> 3, e = q & 7;
      o[q] = (float)of[hh][e] + (float)ob[hh][e];
      s1 += o[q];
      const float am = 0.5f * ((float)af[hh][e] + (float)ab[hh][e]);
      bon += (float)rs[hh][e] * ((float)ks[hh][e] * (1.f + (am - 1.f) * ka[q])) * rk[q];
    }
    s1 += __shfl_xor(s1, 1); s1 += __shfl_xor(s1, 2);
    bon += __shfl_xor(bon, 1); bon += __shfl_xor(bon, 2);
    const float mean = s1 * (1.f / 64.f);
    float s2 = 0.f;
#pragma unroll
    for (int q = 0; q < 16; ++q) { o[q] -= mean; s2 += o[q] * o[q]; }
    s2 += __shfl_xor(s2, 1); s2 += __shfl_xor(s2, 2);
    const float rstd = rsqrtf(s2 * (1.f / 64.f) + 64e-5f);
    h16x8 out[2];
#pragma unroll
    for (int q = 0; q < 16; ++q) {
      const int hh = q >> 3, e = q & 7;
      const float gn = o[q] * rstd * gw[q] + gb[q];
      out[hh][e] = (h16)((gn + bon * (float)vs[hh][e]) * siluf_((float)ga[hh][e]));
    }
    *reinterpret_cast<h16x8*>(GA + idx) = out[0];
    *reinterpret_cast<h16x8*>(GA + idx + 8) = out[1];
  }
}

__device__ __forceinline__ void dft2_tiles(const Params& p, const int swid) {
  const h16* UT = (const h16*)(p.ws + OFF_PB) + NT1K;
  h16* GB = (h16*)(p.ws + OFF_PB) + NT1K + (size_t)NT * 2048;
  for (int it = blockIdx.x; it < 384; it += gridDim.x) {
    Epi e{};
    if (it < 256) {
      int mt = it & 7, g = (it >> 3) & 3, b = it >> 5;
      const h16* A = (const h16*)(p.ws + OFF_TW2048);
      const h16* Bt = UT + (size_t)16777216 + (size_t)b * 4194304 + (size_t)g * 256 * 4096;
      e.o0 = GB + (size_t)(NPR + b * 2048) * 1024;
      e.aux = g * 256;
      e.scale = 0.001381067932004975f;
      gemm_tile<M_DFT2>(swid, A, A, 1 << 30, 4096, Bt, 4096, 4096, mt * 256, 0, e);
    } else {
      int i2 = it - 256;
      int g = i2 & 3, b = i2 >> 2;
      const h16* A = (const h16*)(p.ws + OFF_TW256);
      const h16* Bt = UT + (size_t)b * 524288 + (size_t)g * 256 * 512;
      e.o0 = GB + (size_t)(b * 256) * 1024;
      e.aux = g * 256;
      e.scale = 0.00390625f;
      gemm_tile<M_DFT2>(swid, A, A, 1 << 30, 512, Bt, 512, 512, 0, 0, e);
    }
  }
}

__device__ __forceinline__ void attention(const Params& p, const int swid, int il) {
  const int tid = TIDX, wid = swid, lane = tid & 63;
  const int fr = lane & 15, fq = lane >> 4;
  const h16* Q = (const h16*)(p.ws + OFF_PA);
  const h16* KB = (const h16*)(p.ws + OFF_PB);
  const h16* VB = KB + (size_t)NT * 512;
  const h16* GT = KB + NT1K;
  h16* Y = (h16*)(p.ws + OFF_H);
  h16* Ks = (h16*)smem;
  h16* Vt = Ks + 128 * 72;
  h16* Qs = Vt + 64 * 136;
  constexpr int LDK = 72, LDV = 136;
#pragma unroll 1
  for (int item0 = blockIdx.x; item0 < 1536; item0 += gridDim.x) {
    int item = item0;
    if (item0 < 1024) {
      const int rnd = item0 >> 8, bb = item0 & 255, xcd = bb & 7, slot = bb >> 3;
      const int L = rnd * 32 + slot;
      item = (((L >> 4) * 8 + xcd) << 4) | (L & 15);
    }
    bool isample;
    int seq, kvh, qb, rowbase, nchunk;
    if (item < 1024) { isample = true; qb = item & 15; kvh = (item >> 4) & 7; seq = item >> 7; rowbase = NPR + seq * 2048; nchunk = 5; }
    else { int i2 = item - 1024; isample = false; qb = i2 & 1; kvh = (i2 >> 1) & 7; seq = i2 >> 4; rowbase = seq * 256; nchunk = 2; }
    const int qrow = rowbase + qb * 128 + wid * 16;
    __syncthreads();
#pragma unroll
    for (int g = 0; g < 4; ++g)
#pragma unroll
      for (int it = 0; it < 2; ++it) {
        int piece = lane + it * 64;
        int r = piece >> 3, d0 = (piece & 7) * 8;
        h16x8 v = *reinterpret_cast<const h16x8*>(Q + (size_t)(qrow + r) * 2048 + kvh * 256 + g * 64 + d0);
        *reinterpret_cast<h16x8*>(Qs + (g * 128 + wid * 16 + r) * LDK + d0) = v;
      }
    const h16* qbase = Qs + (wid * 16 + fr) * LDK + fq * 8;
    const h16* kbase = Ks + fr * LDK + fq * 8;
    const h16* vbase = Vt + fr * LDV + fq * 4;
    float mx[4], sinkv[4];
#pragma unroll
    for (int g = 0; g < 4; ++g) { sinkv[g] = p.odd_sink[il * 32 + kvh * 4 + g] * 1.4426950408889634f; mx[g] = sinkv[g]; }
    const int qi = wid * 16 + fr;

    const h16* CK = (const h16*)(p.ws + OFF_CK);
    const h16* CV = (const h16*)(p.ws + OFF_CV);
    auto chunk = [&](int ch, bool& from_cache, int& krow, int& lo, int& hi) -> bool {
      from_cache = false; lo = -100000; hi = 100000; krow = 0;
      if (isample) {
        if (ch < 3) {
          int blk = qb - 1 + ch;
          if (blk < 0 || blk > 15) return false;
          krow = rowbase + blk * 128;
          if (ch == 0) lo = qi;
          if (ch == 2) hi = qi;
        } else { from_cache = true; krow = (ch - 3) * 128; }
      } else krow = rowbase + ch * 128;
      return true;
    };
    auto next_stage = [&](int st) -> int {
      for (++st; st < 2 * nchunk; ++st) {
        bool fc; int kr, lo, hi;
        if (chunk(st % nchunk, fc, kr, lo, hi)) return st;
      }
      return 2 * nchunk;
    };
    h16x8 pk[2], pv[2];
    auto fetch = [&](int st) {
      bool from_cache; int krow, lo, hi;
      chunk(st % nchunk, from_cache, krow, lo, hi);
      const bool withV = st >= nchunk;
#pragma unroll
      for (int it = 0; it < 2; ++it) {
        int piece = tid + it * 512;
        asm volatile("" : "+v"(piece));
        int key = piece >> 3, d0 = (piece & 7) * 8;
        const h16* ks; const h16* vs;
        if (from_cache) {
          size_t off = ((((size_t)seq * 2 + il) * 256 + krow + key) * 8 + kvh) * 64 + d0;
          ks = CK + off; vs = CV + off;
        } else {
          size_t off = (size_t)(krow + key) * 512 + kvh * 64 + d0;
          ks = KB + off; vs = VB + off;
        }
        pk[it] = *reinterpret_cast<const h16x8*>(ks);
        if (withV) {
          const int vkey = piece & 127, vd0 = (piece >> 7) * 8;
          const h16* vs2 = from_cache ? (CV + ((((size_t)seq * 2 + il) * 256 + krow + vkey) * 8 + kvh) * 64 + vd0)
                                      : (VB + (size_t)(krow + vkey) * 512 + kvh * 64 + vd0);
          pv[it] = *reinterpret_cast<const h16x8*>(vs2);
        }
      }
    };
    auto commit = [&](int st) {
      const bool withV = st >= nchunk;
#pragma unroll
      for (int it = 0; it < 2; ++it) {
        int piece = tid + it * 512;
        int key = piece >> 3, d0 = (piece & 7) * 8;
        *reinterpret_cast<h16x8*>(Ks + key * LDK + d0) = pk[it];
        if (withV) {
          const int vkey = piece & 127, vd0 = (piece >> 7) * 8;
#pragma unroll
          for (int q = 0; q < 8; ++q) Vt[(vd0 + q) * LDV + vkey] = pv[it][q];
        }
      }
    };

    int st = next_stage(nchunk - 1);
    fetch(st);
    f32x4 Lacc[4];
#pragma unroll
    for (int g = 0; g < 4; ++g) Lacc[g] = f32x4{0.f, 0.f, 0.f, 0.f};
    const h16x8 ones8 = {(h16)1.f, (h16)1.f, (h16)1.f, (h16)1.f, (h16)1.f, (h16)1.f, (h16)1.f, (h16)1.f};
    f32x4 O[4][4];
#pragma unroll
    for (int g = 0; g < 4; ++g)
#pragma unroll
      for (int n = 0; n < 4; ++n) O[g][n] = f32x4{0.f, 0.f, 0.f, 0.f};
#pragma unroll 1
    while (st < 2 * nchunk) {
      bool from_cache; int krow, lo, hi;
      chunk(st % nchunk, from_cache, krow, lo, hi);
      const bool masked = isample && ((st % nchunk) == 0 || (st % nchunk) == 2);
      __syncthreads();
      commit(st);
      __syncthreads();
      const int nst = next_stage(st);
      if (nst < 2 * nchunk) fetch(nst);
      {
        const int cidx2 = st % nchunk;
        const int k2lo = (masked && cidx2 == 0) ? (wid >> 1) : 0;
        const int k2hi = (masked && cidx2 == 2) ? (wid >> 1) : 3;
#pragma unroll 1
        for (int k2 = k2lo; k2 <= k2hi; ++k2) {
          h16x8 vf[4];
#pragma unroll
          for (int n = 0; n < 4; ++n) {
            h16x4 lo4 = *reinterpret_cast<const h16x4*>(vbase + n * 16 * LDV + k2 * 32);
            h16x4 hi4 = *reinterpret_cast<const h16x4*>(vbase + n * 16 * LDV + k2 * 32 + 16);
            vf[n] = h16x8{lo4[0], lo4[1], lo4[2], lo4[3], hi4[0], hi4[1], hi4[2], hi4[3]};
          }
          h16x8 ka[2][2];
#pragma unroll
          for (int tt = 0; tt < 2; ++tt)
#pragma unroll
            for (int ks = 0; ks < 2; ++ks)
              ka[tt][ks] = *reinterpret_cast<const h16x8*>(kbase + (k2 * 32 + tt * 16) * LDK + ks * 32);
#pragma unroll
          for (int g = 0; g < 4; ++g) {
            const h16x8 q0 = *reinterpret_cast<const h16x8*>(qbase + g * 128 * LDK);
            const h16x8 q1 = *reinterpret_cast<const h16x8*>(qbase + g * 128 * LDK + 32);
            float sv[8];
#pragma unroll
            for (int tt = 0; tt < 2; ++tt) {
              f32x4 sc = {0.f, 0.f, 0.f, 0.f};
              sc = __builtin_amdgcn_mfma_f32_16x16x32_f16(ka[tt][0], q0, sc, 0, 0, 0);
              sc = __builtin_amdgcn_mfma_f32_16x16x32_f16(ka[tt][1], q1, sc, 0, 0, 0);
              if (masked) {
                asm volatile("");
#pragma unroll
                for (int j = 0; j < 4; ++j) {
                  const int kj = k2 * 32 + tt * 16 + fq * 4 + j;
                  sv[tt * 4 + j] = (kj >= lo && kj <= hi) ? sc[j] : -1e30f;
                }
              } else {
#pragma unroll
                for (int j = 0; j < 4; ++j) sv[tt * 4 + j] = sc[j];
              }
            }
            float smax = fmaxf(fmaxf(fmaxf(sv[0], sv[1]), fmaxf(sv[2], sv[3])), fmaxf(fmaxf(sv[4], sv[5]), fmaxf(sv[6], sv[7])));
            if (__any(smax > mx[g] + 8.f)) {
              smax = fmaxf(smax, __shfl_xor(smax, 16));
              smax = fmaxf(smax, __shfl_xor(smax, 32));
              const float mnew = fmaxf(mx[g], smax);
              const float alpha = __builtin_amdgcn_exp2f(mx[g] - mnew);
              mx[g] = mnew;
#pragma unroll
              for (int j = 0; j < 4; ++j) {
                const float al = __shfl(alpha, fq * 4 + j);
                Lacc[g][j] *= al;
#pragma unroll
                for (int n = 0; n < 4; ++n) O[g][n][j] *= al;
              }
            }
            float pe[8];
#pragma unroll
            for (int i = 0; i < 8; ++i) pe[i] = __builtin_amdgcn_exp2f(sv[i] - mx[g]);
            union { unsigned u[4]; h16x8 h; } pfu;
#pragma unroll
            for (int q = 0; q < 4; ++q) {
              auto pk2 = __builtin_amdgcn_cvt_pkrtz(pe[2 * q], pe[2 * q + 1]);
              pfu.u[q] = __builtin_bit_cast(unsigned, pk2);
            }
            const h16x8 pf = pfu.h;
            Lacc[g] = __builtin_amdgcn_mfma_f32_16x16x32_f16(pf, ones8, Lacc[g], 0, 0, 0);
#pragma unroll
            for (int n = 0; n < 4; ++n) O[g][n] = __builtin_amdgcn_mfma_f32_16x16x32_f16(pf, vf[n], O[g][n], 0, 0, 0);
          }
        }
      }
      st = nst;
    }
#pragma unroll
    for (int g = 0; g < 4; ++g) {
      const float sterm = __builtin_amdgcn_exp2f(sinkv[g] - mx[g]);
#pragma unroll
      for (int j = 0; j < 4; ++j) {
        const float li = __builtin_amdgcn_rcpf(Lacc[g][j] + __shfl(sterm, fq * 4 + j));
        h16* srow = Qs + (g * 128 + wid * 16 + fq * 4 + j) * LDK + fr;
#pragma unroll
        for (int n = 0; n < 4; ++n) srow[n * 16] = (h16)(O[g][n][j] * li);
      }
    }
    {
      const int q2 = lane >> 2, g2 = lane & 3;
      const int row = qrow + q2;
      const h16* src = Qs + (g2 * 128 + wid * 16 + q2) * LDK;
      const size_t goff = (size_t)row * 2048 + (kvh * 4 + g2) * 64;
#pragma unroll
      for (int e = 0; e < 8; ++e) {
        const h16x8 ov = *reinterpret_cast<const h16x8*>(src + e * 8);
        const h16x8 gv = *reinterpret_cast<const h16x8*>(GT + goff + e * 8);
        h16x8 yv;
#pragma unroll
        for (int q = 0; q < 8; ++q) yv[q] = (h16)((float)ov[q] * siluf_((float)gv[q]));
        *reinterpret_cast<h16x8*>(Y + goff + e * 8) = yv;
      }
    }
  }
  __syncthreads();
}

__device__ __forceinline__ void gemm_even_in(const Params& p, const int swid, int il) {
  const h16* H = (const h16*)(p.ws + OFF_H);
  const h16* WT = (const h16*)(p.ws + OFF_WT);
  Epi e{};
  e.o0 = (h16*)(p.ws + OFF_PA);
  e.o1 = (h16*)(p.ws + OFF_PB);
  e.o2 = (h16*)(p.ws + OFF_PB) + NT1K;
  e.o3 = (h16*)(p.ws + OFF_PB) + NT1K + (size_t)NT * 2048;
  e.il = il;
  for (int step = 0;; ++step) {
    int pm, pn;
    if (!tile_of(step, 96, 29, pm, pn)) break;
    gemm_tile<M_EVEN_IN>(swid, H, H, 1 << 30, 2048, WT, 2048, 2048, pm * 256, pn * 256, e);
  }
}
__device__ __forceinline__ void gemm_odd_in(const Params& p, const int swid, int il) {
  const h16* H = (const h16*)(p.ws + OFF_H);
  const h16* WT = (const h16*)(p.ws + OFF_WT);
  Epi e{};
  e.o0 = (h16*)(p.ws + OFF_PA);
  e.o1 = (h16*)(p.ws + OFF_PB);
  e.o2 = (h16*)(p.ws + OFF_PB) + (size_t)NT * 512;
  e.o3 = (h16*)(p.ws + OFF_PB) + NT1K;
  e.f0 = p.out + OUT_K;
  e.f1 = p.out + OUT_V;
  e.rope = (const float*)(p.ws + OFF_ROPE);
  e.il = il;
  for (int step = 0;; ++step) {
    int pm, pn;
    if (!tile_of(step, 96, 20, pm, pn)) break;
    gemm_tile<M_ODD_IN>(swid, H, H, 1 << 30, 2048, WT, 2048, 2048, pm * 256, pn * 256, e);
  }
}
__device__ __forceinline__ void gemm_out(const Params& p, const int swid, bool even) {
  const h16* WO = (const h16*)(p.ws + OFF_WO);
  Epi e{};
  e.o0 = (h16*)(p.ws + OFF_C);
  const h16* A0;
  const h16* A1;
  int ksplit, lda;
  if (even) { A0 = (const h16*)(p.ws + OFF_PB); A1 = A0 + NT1K + (size_t)NT * 2048; ksplit = 16; lda = 1024; }
  else { A0 = (const h16*)(p.ws + OFF_H); A1 = A0; ksplit = 1 << 30; lda = 2048; }
  for (int step = 0;; ++step) {
    int pm, pn;
    if (!tile_of(step, 96, 8, pm, pn)) break;
    gemm_tile<M_OUT_F32>(swid, A0, A1, ksplit, lda, WO, 2048, 2048, pm * 256, pn * 256, e);
  }
}

constexpr int NPHASE = 22;
__device__ __forceinline__ void phase_decode(int ph, int& kind, int& layer) {
  if (ph < 2) { kind = ph; layer = 0; return; }
  int q = ph - 2;
  if (q < 6) { layer = 0; kind = 2 + q; if (q >= 4) kind = 6 + (q - 4); return; }
  q -= 6;
  if (q < 4) { layer = 1; kind = (q == 0) ? 8 : (q == 1) ? 9 : (q == 2) ? 6 : 7; return; }
  q -= 4;
  if (q < 6) { layer = 2; kind = 2 + q; if (q >= 4) kind = 6 + (q - 4); return; }
  q -= 6;
  layer = 3;
  kind = (q == 0) ? 8 : (q == 1) ? 9 : (q == 2) ? 6 : 7;
}

__global__ void __launch_bounds__(NTHR, 2) mega(Params p, int ph_lo, int ph_hi) {
  cg::grid_group grid = cg::this_grid();
  const int swid = __builtin_amdgcn_readfirstlane((int)(__builtin_amdgcn_workitem_id_x() >> 6));
  const bool leader_thread = (__builtin_amdgcn_workitem_id_x() == 0);
  volatile LAS unsigned* xst = (volatile LAS unsigned*)(smem + 148480);
  if (leader_thread) { xst[0] = 0u; xst[1] = 0u; }
  __syncthreads();
  XcdBarrier xb;
  xb.bar = (unsigned*)(p.ws + OFF_BAR); xb.x = xb_xcc_id(); xb.st = xst;
  if (leader_thread) (void)xb_add(&xb.bar[XB_XCNT(xb.x)], 1u);
  for (int ph = ph_lo; ph < ph_hi; ++ph) {
    int kind, layer;
    phase_decode(ph, kind, layer);
    const int il = layer >> 1;
#ifdef PROBE_KIND
    if (kind == PROBE_KIND) {
      switch (kind) {
        case 2: gemm_even_in(p, swid, il); break;
        case 3: even_prep(p, swid, il); break;
        case 4: even_scan(p, swid, il); break;
        case 6: gemm_out(p, swid, (layer & 1) == 0); break;
        case 8: gemm_odd_in(p, swid, il); break;
        case 9: attention(p, swid, il); break;
      }
      grid.sync();
    }
#endif
    switch (kind) {
      case 0: phase0(p, swid); break;
      case 1:
        for (int t = blockIdx.x; t < 64; t += gridDim.x) fold_tile(p, swid, 0, t);
        norm_rows(p, swid, -1, 0);
        break;
      case 2: gemm_even_in(p, swid, il); break;
      case 3: dft2_tiles(p, swid); even_prep(p, swid, il); break;
      case 4: even_scan(p, swid, il); break;
      case 5: even_post(p, swid, il); break;
      case 6: gemm_out(p, swid, (layer & 1) == 0); break;
      case 7: {
        if (layer < 3) {
          const int nl = layer + 1;
          if ((nl & 1) == 0)
            for (int t = blockIdx.x; t < 64; t += gridDim.x) fold_tile(p, swid, nl >> 1, t);
          const int nc = conv_items(nl);
          conv_run(p, swid, nl, blockIdx.x, gridDim.x, nc);
        }
        norm_rows(p, swid, layer, layer + 1);
      } break;
      case 8: gemm_odd_in(p, swid, il); break;
      case 9: attention(p, swid, il); break;
    }
    if (ph + 1 < ph_hi) { if (ph == 0) grid.sync(); else xcd_barrier(xb, leader_thread); }
  }
}

extern "C" void kernel_launch(void* const* d_in, const int* in_sizes, int n_in, void* d_out, int out_size, void* d_ws,
                              size_t ws_size, hipStream_t stream) {
  Params p{};
  const float** pp = (const float**)&p;
  for (int i = 0; i < 26; ++i) pp[i] = (const float*)d_in[i];
  p.out = (float*)d_out;
  p.ws = (char*)d_ws;
  static int grid_blocks = 0;
  if (!grid_blocks) {
    hipFuncSetAttribute((const void*)mega, hipFuncAttributeMaxDynamicSharedMemorySize, (int)SMEM_BYTES);
    int dev = 0, cus = 0, per_cu = 0;
    hipGetDevice(&dev);
    hipDeviceGetAttribute(&cus, hipDeviceAttributeMultiprocessorCount, dev);
    hipOccupancyMaxActiveBlocksPerMultiprocessor(&per_cu, mega, NTHR, SMEM_BYTES);
    if (per_cu < 1) per_cu = 1;
    if (per_cu > 1) per_cu = 1;
    grid_blocks = 256;
    if (ws_size < WS_TOTAL) fprintf(stderr, "workspace too small: %zu < %zu\n", ws_size, WS_TOTAL);
  }
#if COOP
  (void)hipMemsetAsync((char*)d_ws + OFF_BAR, 0, XCD_BAR_WORDS_C * 4, stream);
  int lo = 0, hi = NPHASE;
  void* args[] = {&p, &lo, &hi};
  hipError_t e = hipLaunchCooperativeKernel((void*)mega, dim3(grid_blocks), dim3(NTHR), args, SMEM_BYTES, stream);
  if (e != hipSuccess) fprintf(stderr, "cooperative launch failed: %s (grid %d)\n", hipGetErrorString(e), grid_blocks);
#else
  for (int ph = 0; ph < NPHASE; ++ph) mega<<<grid_blocks, NTHR, SMEM_BYTES, stream>>>(p, ph, ph + 1);
#endif
}
```
